# Optimizing an MI355X kernel written in HIP

```python
import math
import jax, jax.numpy as jnp
from jax import lax
import numpy as np

D_MODEL = 1024
BATCH = 4
SEQ = 8192
DEPTH = 1

N_MEM = 256
MIX_WIDTH = D_MODEL
CONV_WIDTH = MIX_WIDTH // 2
CONV_GROUPS = 8
CONV_K = 3
GLA_HEADS = 4
GLA_DV = (MIX_WIDTH - CONV_WIDTH) // GLA_HEADS
GLA_DK = GLA_DV // 2
GLA_K_TOTAL = GLA_HEADS * GLA_DK
GLA_V_TOTAL = GLA_HEADS * GLA_DV
GLA_LOWRANK = 16
GLA_GATE_NORM = 16.0
GLA_CHUNK = 64
XA_HEADS = 4
XA_HEAD_DIM = D_MODEL // XA_HEADS
D_FF = 4 * D_MODEL
EPS = 1e-6

SPLITS = [CONV_WIDTH, CONV_WIDTH, CONV_WIDTH,
          GLA_K_TOTAL, GLA_K_TOTAL, GLA_V_TOTAL, GLA_V_TOTAL,
          GLA_LOWRANK, GLA_LOWRANK]
W_IN_COLS = int(sum(SPLITS))

kernel_name = "hybrid_conv_gla_memxattn_encoder_block"


def rms_norm(x, g):
    xf = x.astype(jnp.float32)
    y = xf * lax.rsqrt(jnp.mean(xf * xf, axis=-1, keepdims=True) + EPS)
    return (y * g.astype(jnp.float32)).astype(x.dtype)


def split_cols(z):
    offs = np.cumsum(SPLITS)[:-1].tolist()
    return jnp.split(z, offs, axis=-1)


def short_conv_mixer(b_gate, c_gate, u, conv_w):
    h = c_gate * u
    hp = jnp.pad(h, ((0, 0), (1, 1), (0, 0)))
    y = (conv_w[0] * hp[:, :-2] + conv_w[1] * hp[:, 1:-1] + conv_w[2] * hp[:, 2:])
    return b_gate * y


def gla_chunked(q, k, v, log_a):
    bsz, s, h, dk = q.shape
    dv = v.shape[-1]
    nc = s // GLA_CHUNK

    def to_chunks(t):
        return t.reshape(bsz, nc, GLA_CHUNK, h, t.shape[-1]).transpose(0, 3, 1, 2, 4)

    q, k, v, la = to_chunks(q), to_chunks(k), to_chunks(v), to_chunks(log_a)
    b = jnp.cumsum(la, axis=3)
    q_t = q * jnp.exp(b)
    k_t = k * jnp.exp(-b)
    mask = jnp.tril(jnp.ones((GLA_CHUNK, GLA_CHUNK), dtype=bool))
    attn = jnp.einsum('bhncd,bhnsd->bhncs', q_t, k_t)
    attn = jnp.where(mask, attn, 0.0)
    o_intra = jnp.einsum('bhncs,bhnsv->bhncv', attn, v)

    g_tot = b[:, :, :, -1, :]
    k_hat = k * jnp.exp(g_tot[:, :, :, None, :] - b)
    u_chunk = jnp.einsum('bhncd,bhncv->bhndv', k_hat, v)

    def step(state, inp):
        g_n, u_n = inp
        new_state = jnp.exp(g_n)[..., None] * state + u_n
        return new_state, state

    s0 = jnp.zeros((bsz, h, dk, dv), jnp.float32)
    _, s_before = lax.scan(step, s0, (jnp.moveaxis(g_tot, 2, 0), jnp.moveaxis(u_chunk, 2, 0)))
    o_inter = jnp.einsum('bhncd,nbhdv->bhncv', q_t, s_before)
    o = o_intra + o_inter
    return o.transpose(0, 2, 3, 1, 4).reshape(bsz, s, h, dv)


def bidirectional_gla(q, k, v, la_f, la_b):
    fwd = gla_chunked(q, k, v, la_f)
    flip = lambda t: jnp.flip(t, axis=1)
    bwd = flip(gla_chunked(flip(q), flip(k), flip(v), flip(la_b)))
    diag = jnp.einsum('bshd,bshd->bsh', q, k)[..., None] * v
    return fwd + bwd - diag


def mixer_layer(x, mix_norm, w_in, conv_w, conv_norm, w_af, b_af, w_ab, b_ab, gla_norm, w_out):
    bsz, s, _ = x.shape
    h = rms_norm(x, mix_norm)
    z = h @ w_in
    cb, cc, cu, q, k, v, g, lr_f, lr_b = split_cols(z)

    y_conv = short_conv_mixer(cb, cc, cu, conv_w)
    y_conv = rms_norm(y_conv.reshape(bsz, s, CONV_GROUPS, CONV_WIDTH // CONV_GROUPS),
                      conv_norm.reshape(CONV_GROUPS, -1)).reshape(bsz, s, CONV_WIDTH)

    f32 = jnp.float32
    qh = q.astype(f32).reshape(bsz, s, GLA_HEADS, GLA_DK) * (GLA_DK ** -0.5)
    kh = k.astype(f32).reshape(bsz, s, GLA_HEADS, GLA_DK)
    vh = v.astype(f32).reshape(bsz, s, GLA_HEADS, GLA_DV)
    la_f = jax.nn.log_sigmoid((lr_f @ w_af + b_af).astype(f32)) / GLA_GATE_NORM
    la_b = jax.nn.log_sigmoid((lr_b @ w_ab + b_ab).astype(f32)) / GLA_GATE_NORM
    la_f = la_f.reshape(bsz, s, GLA_HEADS, GLA_DK)
    la_b = la_b.reshape(bsz, s, GLA_HEADS, GLA_DK)
    o = bidirectional_gla(qh, kh, vh, la_f, la_b)
    o = rms_norm(o, gla_norm).reshape(bsz, s, GLA_V_TOTAL).astype(x.dtype)
    y_gla = o * jax.nn.silu(g)

    y = jnp.concatenate([y_conv, y_gla], axis=-1)
    return y @ w_out


def memory_cross_attention(x, mem, xa_norm, mem_norm, w_xq, w_xkv, w_xo):
    bsz, s, _ = x.shape
    hq = rms_norm(x, xa_norm) @ w_xq
    kv = rms_norm(mem, mem_norm) @ w_xkv
    km, vm = jnp.split(kv, 2, axis=-1)
    qh = hq.reshape(bsz, s, XA_HEADS, XA_HEAD_DIM)
    kh = km.reshape(bsz, N_MEM, XA_HEADS, XA_HEAD_DIM)
    vh = vm.reshape(bsz, N_MEM, XA_HEADS, XA_HEAD_DIM)
    scores = jnp.einsum('bqhd,bmhd->bhqm', qh, kh).astype(jnp.float32) / math.sqrt(XA_HEAD_DIM)
    p = jax.nn.softmax(scores, axis=-1).astype(x.dtype)
    o = jnp.einsum('bhqm,bmhd->bqhd', p, vh).reshape(bsz, s, D_MODEL)
    return o @ w_xo


def sq_relu_mlp(x, mlp_norm, w_up, w_down):
    h = rms_norm(x, mlp_norm) @ w_up
    return jnp.square(jax.nn.relu(h)) @ w_down


def setup_inputs(seed: int = 0) -> dict:
    key = jax.random.key(seed)
    ks = jax.random.split(key, 24)
    L, D = DEPTH, D_MODEL
    nrm = lambda k, shape, fan_in: jax.random.normal(k, shape, jnp.float32) * (fan_in ** -0.5)
    gain = lambda k, shape: 1.0 + 0.01 * jax.random.normal(k, shape, jnp.float32)
    bias = lambda k, shape: 0.1 * jax.random.normal(k, shape, jnp.float32)
    return {
        "x": jax.random.normal(ks[0], (BATCH, SEQ, D), jnp.float32),
        "mem": jax.random.normal(ks[1], (BATCH, N_MEM, D), jnp.float32),
        "mix_norm": gain(ks[2], (L, D)),
        "w_in": nrm(ks[3], (L, D, W_IN_COLS), D),
        "conv_w": nrm(ks[4], (L, CONV_K, CONV_WIDTH), CONV_K),
        "conv_norm": gain(ks[5], (L, CONV_WIDTH)),
        "w_af": nrm(ks[6], (L, GLA_LOWRANK, GLA_K_TOTAL), GLA_LOWRANK),
        "b_af": bias(ks[7], (L, GLA_K_TOTAL)),
        "w_ab": nrm(ks[8], (L, GLA_LOWRANK, GLA_K_TOTAL), GLA_LOWRANK),
        "b_ab": bias(ks[9], (L, GLA_K_TOTAL)),
        "gla_norm": gain(ks[10], (L, GLA_DV)),
        "w_out": nrm(ks[11], (L, MIX_WIDTH, D), MIX_WIDTH),
        "xa_norm": gain(ks[12], (L, D)),
        "mem_norm": gain(ks[13], (L, D)),
        "w_xq": nrm(ks[14], (L, D, D), D),
        "w_xkv": nrm(ks[15], (L, D, 2 * D), D),
        "w_xo": nrm(ks[16], (L, D, D), D),
        "mlp_norm": gain(ks[17], (L, D)),
        "w_up": nrm(ks[18], (L, D, D_FF), D),
        "w_down": nrm(ks[19], (L, D_FF, D), D_FF),
        "final_norm": gain(ks[20], (D,)),
    }


def reference(x, mem, mix_norm, w_in, conv_w, conv_norm, w_af, b_af, w_ab, b_ab, gla_norm,
              w_out, xa_norm, mem_norm, w_xq, w_xkv, w_xo, mlp_norm, w_up, w_down, final_norm):
    for l in range(DEPTH):
        x = x + mixer_layer(x, mix_norm[l], w_in[l], conv_w[l], conv_norm[l], w_af[l], b_af[l],
                            w_ab[l], b_ab[l], gla_norm[l], w_out[l])
        x = x + memory_cross_attention(x, mem, xa_norm[l], mem_norm[l], w_xq[l], w_xkv[l], w_xo[l])
        x = x + sq_relu_mlp(x, mlp_norm[l], w_up[l], w_down[l])
    return rms_norm(x, final_norm)
```

```cpp
#include <hip/hip_runtime.h>
#include <hip/hip_cooperative_groups.h>
#include <cstdio>
#include <cstdint>
namespace cg = cooperative_groups;

#ifndef MK_MODE
#define MK_MODE 1
#endif

#define LAS __attribute__((address_space(3)))
typedef unsigned short bf16_t;
typedef short bf16x8 __attribute__((ext_vector_type(8)));
typedef float f32x4 __attribute__((ext_vector_type(4)));
typedef float f32x2 __attribute__((ext_vector_type(2)));
typedef unsigned u32x4 __attribute__((ext_vector_type(4)));
typedef unsigned u32x2 __attribute__((ext_vector_type(2)));

constexpr int BATCH = 4, SEQ = 8192, T = BATCH * SEQ, D = 1024, NMEM = 256, MROWS = BATCH * NMEM;
constexpr int WIN = 3104, NZ = 3072, NZP = 3328, FF = 4096;
constexpr int ZCB = 0, ZCC = 512, ZCU = 1024, ZQ = 1536, ZK = 1792, ZV = 2048, ZG = 2560;
constexpr int GH = 4, NCH = SEQ / 64, NUNIT = BATCH * GH * NCH;
constexpr float EPS = 1e-6f;

constexpr size_t MiB = 1u << 20;
constexpr size_t WS_CTL = 0;
constexpr size_t WS_WIN = 1 * MiB;
constexpr size_t WS_WOUT = 8 * MiB;
constexpr size_t WS_WXQ = 10 * MiB;
constexpr size_t WS_WXKV = 12 * MiB;
constexpr size_t WS_WXO = 16 * MiB;
constexpr size_t WS_WUP = 18 * MiB;
constexpr size_t WS_WDN = 26 * MiB;
constexpr size_t WS_MN = 34 * MiB;
constexpr size_t WS_KMEM = 36 * MiB;
constexpr size_t WS_VT = 38 * MiB;
constexpr size_t WS_SSQ = 40 * MiB;
constexpr size_t WS_LR = 42 * MiB;
constexpr size_t WS_GG = 46 * MiB;
constexpr size_t WS_XN = 48 * MiB;
constexpr size_t WS_SS = 48 * MiB;
constexpr size_t WS_Y = 112 * MiB;
constexpr size_t WS_HQ = 112 * MiB;
constexpr size_t WS_Z = 176 * MiB;
constexpr size_t WS_P = 176 * MiB;
constexpr size_t WS_O = 240 * MiB;
constexpr size_t WS_UU = 368 * MiB;
constexpr size_t WS_RB = 368 * MiB;
constexpr size_t WS_U = 112 * MiB;
constexpr size_t WS_END = 496 * MiB;

constexpr int LDS_BYTES = 147456;
constexpr int RING_BYTES = 131072;
constexpr int EPI_LDS_OFF = RING_BYTES;

__device__ __forceinline__ unsigned cvt_pk_bf16(float lo, float hi) { unsigned r; asm volatile("v_cvt_pk_bf16_f32 %0, %1, %2" : "=v"(r) : "v"(lo), "v"(hi)); return r; }
__device__ __forceinline__ float bf_lo(unsigned x) { return __uint_as_float(x << 16); }
__device__ __forceinline__ float bf_hi(unsigned x) { return __uint_as_float(x & 0xffff0000u); }
__device__ __forceinline__ float wave_sum(float v) {
#pragma unroll
    for (int o = 1; o < 64; o <<= 1) v += __shfl_xor(v, o);
    return v;
}
#define LDS_WAIT() asm volatile("s_waitcnt lgkmcnt(0)" ::: "memory")
#define VM_WAIT() asm volatile("s_waitcnt vmcnt(0)" ::: "memory")

namespace pg8 {
constexpr int BM = 256, BK = 64, HALF = 128, HTB = HALF * BK * 2, STAGE_BYTES = 8 * HTB, NXCD = 8, WGM = 8;
__host__ __device__ __forceinline__ int lds_byte(int r, int c) { const int st = (r >> 4) * 2 + (c >> 5), rr = r & 15, cc = c & 31, ob = rr * 64 + cc * 2; return st * 1024 + (ob ^ (((ob >> 9) & 1) << 5)); }
__host__ __device__ __forceinline__ void stage_rc(int b, int& R, int& C) { const int st = b / 1024, sb = b % 1024, swz = sb ^ (((sb >> 9) & 1) << 5); R = (st >> 1) * 16 + swz / 64; C = (st & 1) * 32 + (swz % 64) / 2; }
__host__ __device__ __forceinline__ int perm32(int rho) { const int n = rho >> 4, i = rho & 15; return 8 * (i >> 2) + 4 * n + (i & 3); }

struct Unit { int pm, pn; };

struct StaticOrder {
    int nM, nN, nwg, G, c;
    __host__ __device__ void init(int M, int N, int G_, int c_) { nM = M / BM; nN = N / BM; nwg = nM * nN; G = G_; c = c_; }
    __host__ __device__ bool next(int i, Unit& u) const {
        const long L = (long)i * G + c; if (L >= nwg) return false;
        int wgid = (int)L; { const int q = nwg / NXCD, r = nwg % NXCD, xcd = wgid % NXCD, off = wgid / NXCD; wgid = (xcd < r ? xcd * (q + 1) : r * (q + 1) + (xcd - r) * q) + off; }
        const int nig = WGM * nN, gid = wgid / nig, fm = gid * WGM, gsz = (nM - fm) < WGM ? (nM - fm) : WGM;
        u.pm = fm + ((wgid % nig) % gsz); u.pn = (wgid % nig) / gsz; return true;
    }
};

struct ProbPlain { const bf16_t* A; const bf16_t* Bt; int lda, ldb, K;
    __device__ __forceinline__ const char* a_base(const Unit& u) const { return (const char*)(A + (size_t)u.pm * BM * lda); }
    __device__ __forceinline__ const char* b_base(const Unit& u) const { return (const char*)(Bt + (size_t)u.pn * BM * ldb); } };
struct ProbQK { const bf16_t* A; const bf16_t* Bt; int lda, ldb, K;
    __device__ __forceinline__ const char* a_base(const Unit& u) const { return (const char*)(A + (size_t)u.pm * BM * lda + u.pn * 256); }
    __device__ __forceinline__ const char* b_base(const Unit& u) const { return (const char*)(Bt + (size_t)(u.pm >> 5) * 256 * ldb + u.pn * 256); } };
struct ProbPV { const bf16_t* A; const bf16_t* Bt; int lda, ldb, K;
    __device__ __forceinline__ const char* a_base(const Unit& u) const { return (const char*)(A + (size_t)u.pm * BM * lda + u.pn * 256); }
    __device__ __forceinline__ const char* b_base(const Unit& u) const { return (const char*)(Bt + (size_t)((u.pm >> 5) * 4 + u.pn) * 256 * ldb); } };

typedef f32x4 Acc[2][2][4][2];

__device__ __forceinline__ void store8_bf16(bf16_t* p, f32x4 v0, f32x4 v1) {
    u32x4 w; w.x = cvt_pk_bf16(v0[0], v0[1]); w.y = cvt_pk_bf16(v0[2], v0[3]); w.z = cvt_pk_bf16(v1[0], v1[1]); w.w = cvt_pk_bf16(v1[2], v1[3]);
    *(u32x4*)p = w;
}

struct EpiBf16 { static constexpr bool PERM = true; bf16_t* O; int ldc;
    __device__ __forceinline__ void operator()(Acc& acc, const Unit& u, int wr, int wc, int fr, int fq) const {
        const int row0 = u.pm * BM + wr * 64 + fr, col0 = u.pn * BM + wc * 32 + 8 * fq;
#pragma unroll
        for (int ai = 0; ai < 2; ++ai)
#pragma unroll
            for (int m = 0; m < 4; ++m) { bf16_t* rowp = O + (size_t)(row0 + ai * HALF + m * 16) * ldc + col0;
#pragma unroll
                for (int bj = 0; bj < 2; ++bj) store8_bf16(rowp + bj * HALF, acc[ai][bj][m][0], acc[ai][bj][m][1]); }
    }
};
struct EpiZ { static constexpr bool PERM = true; bf16_t* Z; float* LR;
    __device__ __forceinline__ void operator()(Acc& acc, const Unit& u, int wr, int wc, int fr, int fq) const {
        const int row0 = u.pm * BM + wr * 64 + fr;
        if (u.pn < 12) {
            const int col0 = u.pn * BM + wc * 32 + 8 * fq;
#pragma unroll
            for (int ai = 0; ai < 2; ++ai)
#pragma unroll
                for (int m = 0; m < 4; ++m) { bf16_t* rowp = Z + (size_t)(row0 + ai * HALF + m * 16) * NZ + col0;
#pragma unroll
                    for (int bj = 0; bj < 2; ++bj) store8_bf16(rowp + bj * HALF, acc[ai][bj][m][0], acc[ai][bj][m][1]); }
        } else if (wc == 0) {
#pragma unroll
            for (int ai = 0; ai < 2; ++ai)
#pragma unroll
                for (int m = 0; m < 4; ++m) { float* p = LR + (size_t)(row0 + ai * HALF + m * 16) * 32 + 8 * fq;
                    *(f32x4*)p = acc[ai][0][m][0]; *(f32x4*)(p + 4) = acc[ai][0][m][1]; }
        }
    }
};
struct EpiKV { static constexpr bool PERM = true; bf16_t* Kmem; bf16_t* Vt;
    __device__ __forceinline__ void operator()(Acc& acc, const Unit& u, int wr, int wc, int fr, int fq) const {
        if (u.pn < 4) {
            const int row0 = u.pm * BM + wr * 64 + fr, col0 = u.pn * BM + wc * 32 + 8 * fq;
#pragma unroll
            for (int ai = 0; ai < 2; ++ai)
#pragma unroll
                for (int m = 0; m < 4; ++m) { bf16_t* rowp = Kmem + (size_t)(row0 + ai * HALF + m * 16) * 1024 + col0;
#pragma unroll
                    for (int bj = 0; bj < 2; ++bj) store8_bf16(rowp + bj * HALF, acc[ai][bj][m][0], acc[ai][bj][m][1]); }
        } else {
            bf16_t* vb = Vt + (size_t)(u.pm * 4 + (u.pn - 4)) * 256 * 256;
#pragma unroll
            for (int ai = 0; ai < 2; ++ai)
#pragma unroll
                for (int m = 0; m < 4; ++m) { const int key = ai * HALF + wr * 64 + m * 16 + fr;
#pragma unroll
                    for (int bj = 0; bj < 2; ++bj) { const int dim0 = bj * HALF + wc * 32 + 8 * fq;
#pragma unroll
                        for (int n = 0; n < 2; ++n) { const f32x4 v = acc[ai][bj][m][n]; const unsigned a = cvt_pk_bf16(v[0], v[1]), b = cvt_pk_bf16(v[2], v[3]);
                            bf16_t* q = vb + (size_t)(dim0 + 4 * n) * 256 + key;
                            q[0] = (bf16_t)(a & 0xffffu); q[256] = (bf16_t)(a >> 16); q[512] = (bf16_t)(b & 0xffffu); q[768] = (bf16_t)(b >> 16); } } }
        }
    }
};
template <bool NORM> struct EpiRes { static constexpr bool PERM = false; const float* base; float* out; const float* gain; bf16_t* XN; float* SSQ;
    __device__ __forceinline__ void operator()(Acc& acc, const Unit& u, int wr, int wc, int fr, int fq) const {
        const int row0 = u.pm * BM + wr * 64 + fr, col0 = u.pn * BM + wc * 32 + 4 * fq;
        f32x4 gv[2][2];
        if (NORM) {
#pragma unroll
            for (int bj = 0; bj < 2; ++bj)
#pragma unroll
                for (int n = 0; n < 2; ++n) gv[bj][n] = *(const f32x4*)(gain + col0 + bj * HALF + n * 16);
        }
#pragma unroll
        for (int ai = 0; ai < 2; ++ai)
#pragma unroll
            for (int m = 0; m < 4; ++m) { const int row = row0 + ai * HALF + m * 16; const size_t off = (size_t)row * D + col0; float ss = 0.f;
#pragma unroll
                for (int bj = 0; bj < 2; ++bj)
#pragma unroll
                    for (int n = 0; n < 2; ++n) { const f32x4 v = *(const f32x4*)(base + off + bj * HALF + n * 16) + acc[ai][bj][m][n];
                        *(f32x4*)(out + off + bj * HALF + n * 16) = v;
                        if (NORM) { ss += (v[0] * v[0] + v[1] * v[1]) + (v[2] * v[2] + v[3] * v[3]); const f32x4 w = v * gv[bj][n];
                            u32x2 pk; pk.x = cvt_pk_bf16(w[0], w[1]); pk.y = cvt_pk_bf16(w[2], w[3]); *(u32x2*)(XN + off + bj * HALF + n * 16) = pk; } }
                if (NORM) { ss += __shfl_xor(ss, 16); ss += __shfl_xor(ss, 32); if (fq == 0) SSQ[(size_t)row * 16 + u.pn * 4 + wc] = ss; }
                if (m & 1) asm volatile("" ::: "memory"); }
    }
};
template <int ACT> struct EpiScale { static constexpr bool PERM = true; bf16_t* O; int ldc; const float* SSQ; float post;
    __device__ __forceinline__ void operator()(Acc& acc, const Unit& u, int wr, int wc, int fr, int fq) const {
        const int row0 = u.pm * BM + wr * 64 + fr, col0 = u.pn * BM + wc * 32 + 8 * fq;
#pragma unroll
        for (int ai = 0; ai < 2; ++ai)
#pragma unroll
            for (int m = 0; m < 4; ++m) { const int row = row0 + ai * HALF + m * 16; const f32x4* sp = (const f32x4*)(SSQ + (size_t)row * 16);
                const f32x4 s4 = (sp[0] + sp[1]) + (sp[2] + sp[3]); const float s = (s4[0] + s4[1]) + (s4[2] + s4[3]);
                const float rs = rsqrtf(s * (1.0f / D) + EPS) * post; bf16_t* rowp = O + (size_t)row * ldc + col0;
#pragma unroll
                for (int bj = 0; bj < 2; ++bj) { f32x4 v0 = acc[ai][bj][m][0] * rs, v1 = acc[ai][bj][m][1] * rs;
                    if (ACT == 1) {
#pragma unroll
                        for (int i = 0; i < 4; ++i) { const float a = fmaxf(v0[i], 0.f), b = fmaxf(v1[i], 0.f); v0[i] = a * a; v1[i] = b * b; } }
                    store8_bf16(rowp + bj * HALF, v0, v1); } }
    }
};
struct EpiSoftmax { static constexpr bool PERM = true; bf16_t* P; int ldc; LAS float* red;
    __device__ __forceinline__ void operator()(Acc& acc, const Unit& u, int wr, int wc, int fr, int fq) const {
        LAS float* red0 = red; LAS float* red1 = red + 1024;
#pragma unroll
        for (int ai = 0; ai < 2; ++ai)
#pragma unroll
            for (int m = 0; m < 4; ++m) { float mx = -3.0e38f;
#pragma unroll
                for (int bj = 0; bj < 2; ++bj)
#pragma unroll
                    for (int n = 0; n < 2; ++n) { const f32x4 v = acc[ai][bj][m][n]; mx = fmaxf(mx, fmaxf(fmaxf(v[0], v[1]), fmaxf(v[2], v[3]))); }
                mx = fmaxf(mx, __shfl_xor(mx, 16)); mx = fmaxf(mx, __shfl_xor(mx, 32));
                if (fq == 0) red0[(ai * HALF + wr * 64 + m * 16 + fr) * 4 + wc] = mx; }
        LDS_WAIT(); __builtin_amdgcn_s_barrier(); asm volatile("" ::: "memory");
#pragma unroll
        for (int ai = 0; ai < 2; ++ai)
#pragma unroll
            for (int m = 0; m < 4; ++m) { const int r = ai * HALF + wr * 64 + m * 16 + fr; const f32x4 q = *(const LAS f32x4*)(red0 + r * 4);
                const float M = fmaxf(fmaxf(q[0], q[1]), fmaxf(q[2], q[3])); float s = 0.f;
#pragma unroll
                for (int bj = 0; bj < 2; ++bj)
#pragma unroll
                    for (int n = 0; n < 2; ++n) { f32x4 v = acc[ai][bj][m][n];
#pragma unroll
                        for (int i = 0; i < 4; ++i) { v[i] = __expf(v[i] - M); s += v[i]; }
                        acc[ai][bj][m][n] = v; }
                s += __shfl_xor(s, 16); s += __shfl_xor(s, 32);
                if (fq == 0) red1[r * 4 + wc] = s; }
        LDS_WAIT(); __builtin_amdgcn_s_barrier(); asm volatile("" ::: "memory");
        const int row0 = u.pm * BM + wr * 64 + fr, col0 = u.pn * BM + wc * 32 + 8 * fq;
#pragma unroll
        for (int ai = 0; ai < 2; ++ai)
#pragma unroll
            for (int m = 0; m < 4; ++m) { const int r = ai * HALF + wr * 64 + m * 16 + fr; const f32x4 q = *(const LAS f32x4*)(red1 + r * 4);
                const float inv = 1.0f / ((q[0] + q[1]) + (q[2] + q[3])); bf16_t* rowp = P + (size_t)(row0 + ai * HALF + m * 16) * ldc + col0;
#pragma unroll
                for (int bj = 0; bj < 2; ++bj) store8_bf16(rowp + bj * HALF, acc[ai][bj][m][0] * inv, acc[ai][bj][m][1] * inv); }
    }
};

template <class Epi, class Prob, class Sched, bool ALIGN_EPI>
__device__ __forceinline__ void gemm_phase(LAS unsigned char* lds, int tid, int wid, const Prob g, const Sched& S, const Epi& E) {
    const int lane = tid & 63, wr = wid >> 2, wc = wid & 3, fr = lane & 15, fq = lane >> 4;
    const int K = g.K, nt = K / BK;
    unsigned voffA[2], voffB[2];
#pragma unroll
    for (int i = 0; i < 2; ++i) { int R, C; stage_rc(tid * 16 + i * 8192, R, C); const int Rb = Epi::PERM ? ((R & ~31) + perm32(R & 31)) : R;
        voffA[i] = (unsigned)(R * g.lda + C) * 2u; voffB[i] = (unsigned)(Rb * g.ldb + C) * 2u; }
    const size_t kstep = (size_t)(BK * 2);
    const size_t hstepA = (size_t)HALF * g.lda * 2, hstepB = (size_t)HALF * g.ldb * 2;
    const unsigned ldsw = (unsigned)wid * 1024u;
    const int aoff = lds_byte(wr * 64 + fr, fq * 8), boff = lds_byte(wc * 32 + fr, fq * 8);
#define PG8_SA(b, h) (((b) * 2 + (h)) * HTB)
#define PG8_SB(b, h) ((4 + (b) * 2 + (h)) * HTB)
#define PG8_STAGE(bufoff, gbase, voff) do { _Pragma("unroll") for (int _i = 0; _i < 2; ++_i) \
        __builtin_amdgcn_global_load_lds((const unsigned*)((const char*)(gbase) + (voff)[_i]), (LAS unsigned*)(lds + (bufoff) + ldsw + _i * 8192), 16, 0, 0); } while (0)
#define PG8_LDA(dst, b, h) do { _Pragma("unroll") for (int m = 0; m < 4; ++m) _Pragma("unroll") for (int k = 0; k < 2; ++k) dst[m][k] = *(const LAS bf16x8*)(lds + PG8_SA(b, h) + aoff + m * 2048 + k * 1024); } while (0)
#define PG8_LDB(dst, b, h) do { _Pragma("unroll") for (int n = 0; n < 2; ++n) _Pragma("unroll") for (int k = 0; k < 2; ++k) dst[n][k] = *(const LAS bf16x8*)(lds + PG8_SB(b, h) + boff + n * 2048 + k * 1024); } while (0)
#define PG8_MMA(ai, bj, At, Bt) do { __builtin_amdgcn_s_setprio(1); _Pragma("unroll") for (int m = 0; m < 4; ++m) _Pragma("unroll") for (int n = 0; n < 2; ++n) _Pragma("unroll") for (int k = 0; k < 2; ++k) \
        acc[ai][bj][m][n] = __builtin_amdgcn_mfma_f32_16x16x32_bf16(Bt[n][k], At[m][k], acc[ai][bj][m][n], 0, 0, 0); __builtin_amdgcn_s_setprio(0); } while (0)
#define PG8_WAIT_V(n) asm volatile("s_waitcnt vmcnt(" #n ")" ::: "memory")
#define PG8_WAIT_L(n) asm volatile("s_waitcnt lgkmcnt(" #n ")" ::: "memory")
#define PG8_BAR __builtin_amdgcn_s_barrier()
#define PG8_SCHED __builtin_amdgcn_sched_barrier(0)
    Unit cur, nxt; int ui = 0;
    if (!S.next(0, cur)) return;
    Acc acc;
#pragma unroll
    for (int a = 0; a < 2; ++a)
#pragma unroll
        for (int b = 0; b < 2; ++b)
#pragma unroll
            for (int m = 0; m < 4; ++m)
#pragma unroll
                for (int n = 0; n < 2; ++n) acc[a][b][m][n] = (f32x4){0.f, 0.f, 0.f, 0.f};
    bf16x8 At[4][2], B0[2][2], B1[2][2];
    const char* cA = g.a_base(cur); const char* cB = g.b_base(cur);
    PG8_STAGE(PG8_SB(0, 0), cB, voffB); PG8_STAGE(PG8_SB(0, 1), cB + hstepB, voffB); PG8_STAGE(PG8_SA(0, 0), cA, voffA); PG8_STAGE(PG8_SA(0, 1), cA + hstepA, voffA);
    if (wr == 1) PG8_BAR;
    PG8_WAIT_V(2); PG8_BAR;
    PG8_STAGE(PG8_SB(1, 0), cB + kstep, voffB); PG8_STAGE(PG8_SA(1, 0), cA + kstep, voffA); PG8_STAGE(PG8_SB(1, 1), cB + hstepB + kstep, voffB);
    PG8_WAIT_V(6); PG8_BAR;
    for (;;) {
        const bool has_next = S.next(ui + 1, nxt);
        const char* nA = has_next ? g.a_base(nxt) : cA; const char* nB = has_next ? g.b_base(nxt) : cB;
#pragma nounroll
        for (int t = 0; t < nt; t += 2) {
            const bool last = (t == nt - 2);
            const char* a1 = cA + (size_t)(t + 1) * kstep;
            const char* a2 = last ? nA : cA + (size_t)(t + 2) * kstep; const char* b2 = last ? nB : cB + (size_t)(t + 2) * kstep;
            const char* a3 = a2 + kstep; const char* b3 = b2 + kstep;
            PG8_LDB(B0, 0, 0); PG8_LDB(B1, 0, 1); PG8_SCHED; PG8_LDA(At, 0, 0); PG8_STAGE(PG8_SA(1, 1), a1 + hstepA, voffA);
            PG8_WAIT_V(8); PG8_WAIT_L(0); PG8_BAR; PG8_MMA(0, 0, At, B0); PG8_MMA(0, 1, At, B1); PG8_BAR; PG8_SCHED;
            PG8_LDA(At, 0, 1); PG8_STAGE(PG8_SB(0, 0), b2, voffB); PG8_STAGE(PG8_SB(0, 1), b2 + hstepB, voffB); PG8_STAGE(PG8_SA(0, 0), a2, voffA);
            PG8_WAIT_V(8); PG8_WAIT_L(0); PG8_BAR; PG8_MMA(1, 0, At, B0); PG8_MMA(1, 1, At, B1); PG8_BAR; PG8_SCHED;
            PG8_LDB(B0, 1, 0); PG8_LDB(B1, 1, 1); PG8_SCHED; PG8_LDA(At, 1, 0); PG8_STAGE(PG8_SA(0, 1), a2 + hstepA, voffA);
            PG8_WAIT_V(8); PG8_WAIT_L(0); PG8_BAR; PG8_MMA(0, 0, At, B0); PG8_MMA(0, 1, At, B1); PG8_BAR; PG8_SCHED;
            PG8_LDA(At, 1, 1); PG8_STAGE(PG8_SB(1, 0), b3, voffB); PG8_STAGE(PG8_SB(1, 1), b3 + hstepB, voffB); PG8_STAGE(PG8_SA(1, 0), a3, voffA);
            PG8_WAIT_V(8); PG8_WAIT_L(0); PG8_BAR; PG8_MMA(1, 0, At, B0); PG8_MMA(1, 1, At, B1); PG8_BAR; PG8_SCHED;
        }
        if constexpr (ALIGN_EPI) { if (wr == 0) PG8_BAR; }
        E(acc, cur, wr, wc, fr, fq);
        if (!has_next) break;
#pragma unroll
        for (int a = 0; a < 2; ++a)
#pragma unroll
            for (int b = 0; b < 2; ++b)
#pragma unroll
                for (int m = 0; m < 4; ++m)
#pragma unroll
                    for (int n = 0; n < 2; ++n) acc[a][b][m][n] = (f32x4){0.f, 0.f, 0.f, 0.f};
        cur = nxt; cA = nA; cB = nB; ++ui;
        if constexpr (ALIGN_EPI) { if (wr == 1) PG8_BAR; }
    }
    PG8_WAIT_V(0);
    if constexpr (!ALIGN_EPI) { if (wr == 0) PG8_BAR; }
    PG8_BAR;
#undef PG8_SA
#undef PG8_SB
#undef PG8_STAGE
#undef PG8_LDA
#undef PG8_LDB
#undef PG8_MMA
#undef PG8_WAIT_V
#undef PG8_WAIT_L
#undef PG8_BAR
#undef PG8_SCHED
}
}

struct Args { const float* in[21]; float* out; unsigned char* ws; int ph_lo, ph_hi; };
enum { I_X = 0, I_MEM, I_MIXN, I_WIN, I_CONVW, I_CONVN, I_WAF, I_BAF, I_WAB, I_BAB, I_GLAN, I_WOUT, I_XAN, I_MEMN, I_WXQ, I_WXKV, I_WXO, I_MLPN, I_WUP, I_WDN, I_FINN };
constexpr int N_PHASES = 13;

struct Ctx { LAS unsigned char* lds; int tid, lane, wave, gw, NGW, G; };

__device__ __forceinline__ void p0_transpose_item(const float* W, int K, int N, bf16_t* WT, LAS float* scr, int item, int lane) {
    const int nblk = N / 32, kb = item / nblk, nb = item % nblk, k0 = 64 * kb, n0 = 32 * nb;
#pragma unroll 8
    for (int i = 0; i < 32; ++i) { const int kk = 2 * i + (lane >> 5); scr[kk * 33 + (lane & 31)] = W[(size_t)(k0 + kk) * N + n0 + (lane & 31)]; }
    LDS_WAIT(); asm volatile("" ::: "memory");
    const int c = lane & 7;
#pragma unroll
    for (int j = 0; j < 4; ++j) { const int n = (lane >> 3) + 8 * j; const LAS float* s = scr + (8 * c) * 33 + n;
        u32x4 o; o.x = cvt_pk_bf16(s[0 * 33], s[1 * 33]); o.y = cvt_pk_bf16(s[2 * 33], s[3 * 33]); o.z = cvt_pk_bf16(s[4 * 33], s[5 * 33]); o.w = cvt_pk_bf16(s[6 * 33], s[7 * 33]);
        *(u32x4*)(WT + (size_t)(n0 + n) * K + k0 + 8 * c) = o; }
    LDS_WAIT(); asm volatile("" ::: "memory");
}
__device__ __forceinline__ void rms_row_to_bf16(const float* xrow, const float* gain, bf16_t* orow, int lane) {
    const f32x4* xr = (const f32x4*)xrow + lane; const f32x4* gr = (const f32x4*)gain + lane;
    f32x4 v[4]; float s = 0.f;
#pragma unroll
    for (int j = 0; j < 4; ++j) { v[j] = xr[64 * j]; s += (v[j][0] * v[j][0] + v[j][1] * v[j][1]) + (v[j][2] * v[j][2] + v[j][3] * v[j][3]); }
    const float rstd = rsqrtf(wave_sum(s) * (1.f / D) + EPS);
    u32x2* o8 = (u32x2*)orow + lane;
#pragma unroll
    for (int j = 0; j < 4; ++j) { const f32x4 w = v[j] * rstd * gr[64 * j]; u32x2 pk; pk.x = cvt_pk_bf16(w[0], w[1]); pk.y = cvt_pk_bf16(w[2], w[3]); o8[64 * j] = pk; }
}
__device__ __forceinline__ void phase_prologue(const Ctx& c, const Args& a) {
    unsigned char* ws = a.ws;
    LAS float* scr = (LAS float*)(c.lds + c.wave * 16384);
    struct WD { const float* W; int K, N; size_t off; };
    const WD wd[7] = { {a.in[I_WIN], D, WIN, WS_WIN}, {a.in[I_WOUT], D, D, WS_WOUT}, {a.in[I_WXQ], D, D, WS_WXQ}, {a.in[I_WXKV], D, 2 * D, WS_WXKV},
                       {a.in[I_WXO], D, D, WS_WXO}, {a.in[I_WUP], D, FF, WS_WUP}, {a.in[I_WDN], FF, D, WS_WDN} };
#pragma unroll
    for (int w = 0; w < 7; ++w) { const int nitems = (wd[w].K / 64) * (wd[w].N / 32);
        for (int it = c.gw; it < nitems; it += c.NGW) p0_transpose_item(wd[w].W, wd[w].K, wd[w].N, (bf16_t*)(ws + wd[w].off), scr, it, c.lane); }
    { u32x4* z = (u32x4*)(ws + WS_WIN + (size_t)WIN * D * 2); const int n16 = (NZP - WIN) * D * 2 / 16;
      for (int i = c.gw * 64 + c.lane; i < n16; i += c.NGW * 64) z[i] = (u32x4){0u, 0u, 0u, 0u}; }
    for (int m = c.gw; m < T; m += c.NGW) rms_row_to_bf16(a.in[I_X] + (size_t)m * D, a.in[I_MIXN], (bf16_t*)(ws + WS_XN) + (size_t)m * D, c.lane);
    for (int m = c.gw; m < MROWS; m += c.NGW) rms_row_to_bf16(a.in[I_MEM] + (size_t)m * D, a.in[I_MEMN], (bf16_t*)(ws + WS_MN) + (size_t)m * D, c.lane);
}

constexpr int GS = 144;
constexpr int L_QF = 0, L_KF = 9216, L_QB = 18432, L_KB = 27648, L_VT = 36864, L_AC = 55296, L_RED = 64512, L_WA = 66560, L_WB = 74752;
__device__ __forceinline__ bf16x8 gfrag(const LAS unsigned char* base, int r0, int ks, int fr, int fq) { return *(const LAS bf16x8*)(base + (r0 + fr) * GS + ks * 64 + fq * 16); }
__device__ __forceinline__ float logsig(float z) { return fminf(z, 0.f) - __logf(1.0f + __expf(-fabsf(z))); }

__device__ __forceinline__ void gla_load_w(const Ctx& c, const Args& a, int h) {
    const int idx = c.tid * 4, dir = idx >> 10, r = (idx >> 6) & 15, d = idx & 63;
    const float* src = (dir ? a.in[I_WAB] : a.in[I_WAF]) + r * 256 + h * 64 + d;
    *(LAS f32x4*)(c.lds + L_WA + idx * 4) = *(const f32x4*)src;
    if (c.tid < 32) { const int dr = c.tid >> 4, dd = (c.tid & 15) * 4; *(LAS f32x4*)(c.lds + L_WB + (dr * 64 + dd) * 4) = *(const f32x4*)((dr ? a.in[I_BAB] : a.in[I_BAF]) + h * 64 + dd); }
}
template <bool PASS_A>
__device__ __forceinline__ void gla_prep(const Ctx& c, const Args& a, int b, int h, int n, float* Gf, float* Gb) {
    const bf16_t* Z = (const bf16_t*)(a.ws + WS_Z); const float* LR = (const float*)(a.ws + WS_LR);
    const int t = c.lane, d0 = 8 * c.wave; const size_t row = (size_t)b * SEQ + n * 64 + t;
    const f32x4* lrp = (const f32x4*)(LR + row * 32);
    f32x4 l[8];
#pragma unroll
    for (int i = 0; i < 8; ++i) l[i] = lrp[i];
    const u32x4 qraw = *(const u32x4*)(Z + row * NZ + ZQ + h * 64 + d0), kraw = *(const u32x4*)(Z + row * NZ + ZK + h * 64 + d0);
    float qv[8], kv[8];
#pragma unroll
    for (int i = 0; i < 4; ++i) { qv[2 * i] = bf_lo(qraw[i]); qv[2 * i + 1] = bf_hi(qraw[i]); kv[2 * i] = bf_lo(kraw[i]); kv[2 * i + 1] = bf_hi(kraw[i]); }
    const LAS float* WA = (const LAS float*)(c.lds + L_WA); const LAS float* WB = (const LAS float*)(c.lds + L_WB);
    float zf[8], zb[8];
    { const f32x4 b0 = *(const LAS f32x4*)(WB + d0), b1 = *(const LAS f32x4*)(WB + d0 + 4), b2 = *(const LAS f32x4*)(WB + 64 + d0), b3 = *(const LAS f32x4*)(WB + 64 + d0 + 4);
#pragma unroll
      for (int i = 0; i < 4; ++i) { zf[i] = b0[i]; zf[4 + i] = b1[i]; zb[i] = b2[i]; zb[4 + i] = b3[i]; } }
#pragma unroll
    for (int r = 0; r < 16; ++r) {
        const f32x4 f0 = *(const LAS f32x4*)(WA + r * 64 + d0), f1 = *(const LAS f32x4*)(WA + r * 64 + d0 + 4);
        const f32x4 g0 = *(const LAS f32x4*)(WA + 1024 + r * 64 + d0), g1 = *(const LAS f32x4*)(WA + 1024 + r * 64 + d0 + 4);
        const float lf = l[r >> 2][r & 3], lb = l[4 + (r >> 2)][r & 3];
#pragma unroll
        for (int i = 0; i < 4; ++i) { zf[i] += lf * f0[i]; zf[4 + i] += lf * f1[i]; zb[i] += lb * g0[i]; zb[4 + i] += lb * g1[i]; }
        if (r & 1) {
#pragma unroll
            for (int i = 0; i < 8; ++i) asm volatile("" : "+v"(zf[i]), "+v"(zb[i])); }
    }
    float o0[8], o1[8], o2[8], o3[8];
#pragma unroll
    for (int i = 0; i < 8; ++i) {
        float bb = logsig(zf[i]) * (1.0f / 16.0f), cc = logsig(zb[i]) * (1.0f / 16.0f);
#pragma unroll
        for (int off = 1; off < 64; off <<= 1) { const float y = __shfl_up(bb, off); if (t >= off) bb += y; const float w = __shfl_down(cc, off); if (t + off < 64) cc += w; }
        if (PASS_A) {
            const float b63 = __shfl(bb, 63), c0 = __shfl(cc, 0);
            o0[i] = kv[i] * __expf(b63 - bb); o1[i] = kv[i] * __expf(c0 - cc);
            if (t == 63) Gf[d0 + i] = bb;
            if (t == 0) Gb[d0 + i] = cc;
        } else {
            const float eb = __expf(bb), ec = __expf(cc);
            o0[i] = qv[i] * 0.125f * eb; o1[i] = kv[i] * __expf(-bb); o2[i] = qv[i] * 0.125f * ec; o3[i] = kv[i] * __expf(-cc);
        }
    }
    if (PASS_A) {
#pragma unroll
        for (int i = 0; i < 8; i += 2) { const unsigned pf = cvt_pk_bf16(o0[i], o0[i + 1]), pb = cvt_pk_bf16(o1[i], o1[i + 1]);
            *(LAS bf16_t*)(c.lds + L_QF + (d0 + i) * GS + t * 2) = (bf16_t)(pf & 0xffffu); *(LAS bf16_t*)(c.lds + L_QF + (d0 + i + 1) * GS + t * 2) = (bf16_t)(pf >> 16);
            *(LAS bf16_t*)(c.lds + L_KF + (d0 + i) * GS + t * 2) = (bf16_t)(pb & 0xffffu); *(LAS bf16_t*)(c.lds + L_KF + (d0 + i + 1) * GS + t * 2) = (bf16_t)(pb >> 16); }
    } else {
        u32x4 w0, w1, w2, w3;
#pragma unroll
        for (int i = 0; i < 4; ++i) { w0[i] = cvt_pk_bf16(o0[2 * i], o0[2 * i + 1]); w1[i] = cvt_pk_bf16(o1[2 * i], o1[2 * i + 1]); w2[i] = cvt_pk_bf16(o2[2 * i], o2[2 * i + 1]); w3[i] = cvt_pk_bf16(o3[2 * i], o3[2 * i + 1]); }
        *(LAS u32x4*)(c.lds + L_QF + t * GS + d0 * 2) = w0; *(LAS u32x4*)(c.lds + L_KF + t * GS + d0 * 2) = w1;
        *(LAS u32x4*)(c.lds + L_QB + t * GS + d0 * 2) = w2; *(LAS u32x4*)(c.lds + L_KB + t * GS + d0 * 2) = w3;
    }
    const int e0 = 16 * c.wave; const u32x4* vp = (const u32x4*)(Z + row * NZ + ZV + h * 128 + e0);
    const u32x4 va = vp[0], vb = vp[1];
#pragma unroll
    for (int i = 0; i < 4; ++i) {
        *(LAS bf16_t*)(c.lds + L_VT + (e0 + 2 * i) * GS + t * 2) = (bf16_t)(va[i] & 0xffffu); *(LAS bf16_t*)(c.lds + L_VT + (e0 + 2 * i + 1) * GS + t * 2) = (bf16_t)(va[i] >> 16);
        *(LAS bf16_t*)(c.lds + L_VT + (e0 + 8 + 2 * i) * GS + t * 2) = (bf16_t)(vb[i] & 0xffffu); *(LAS bf16_t*)(c.lds + L_VT + (e0 + 8 + 2 * i + 1) * GS + t * 2) = (bf16_t)(vb[i] >> 16); }
}

__device__ __forceinline__ void phase_gla_a(const Ctx& c, const Args& a) {
    float* UU = (float*)(a.ws + WS_UU); float* GG = (float*)(a.ws + WS_GG);
    const int fr = c.lane & 15, fq = c.lane >> 4, w = c.wave;
    int h_loaded = -1;
    for (int uu = blockIdx.x; uu < NUNIT; uu += c.G) {
        const int h = uu & 3, n = (uu >> 2) & (NCH - 1), b = uu >> 9, unit = (b * GH + h) * NCH + n;
        __syncthreads();
        if (h != h_loaded) { gla_load_w(c, a, h); h_loaded = h; __syncthreads(); }
        gla_prep<true>(c, a, b, h, n, GG + (size_t)unit * 64, GG + (size_t)(NUNIT + unit) * 64);
        __syncthreads();
        bf16x8 av[2];
#pragma unroll
        for (int ks = 0; ks < 2; ++ks) av[ks] = gfrag(c.lds + L_VT, 16 * w, ks, fr, fq);
#pragma unroll
        for (int dir = 0; dir < 2; ++dir)
#pragma unroll
            for (int dt = 0; dt < 4; ++dt) { f32x4 acc = (f32x4){0.f, 0.f, 0.f, 0.f};
#pragma unroll
                for (int ks = 0; ks < 2; ++ks) acc = __builtin_amdgcn_mfma_f32_16x16x32_bf16(av[ks], gfrag(c.lds + (dir ? L_KF : L_QF), 16 * dt, ks, fr, fq), acc, 0, 0, 0);
                float* up = UU + ((size_t)(dir * NUNIT + unit) * 128 + 16 * w + 4 * fq) * 64 + 16 * dt + fr;
#pragma unroll
                for (int i = 0; i < 4; ++i) up[i * 64] = acc[i]; }
    }
}
__device__ __forceinline__ void phase_conv(const Ctx& c, const Args& a) {
    const bf16_t* Z = (const bf16_t*)(a.ws + WS_Z); bf16_t* Y = (bf16_t*)(a.ws + WS_Y);
    const float* cw = a.in[I_CONVW]; const float* cn = a.in[I_CONVN];
    const int c0 = 8 * c.lane;
    float w0[8], w1[8], w2[8], gn[8];
#pragma unroll
    for (int i = 0; i < 8; ++i) { w0[i] = cw[c0 + i]; w1[i] = cw[512 + c0 + i]; w2[i] = cw[1024 + c0 + i]; gn[i] = cn[c0 + i]; }
    for (int tok = c.gw; tok < T; tok += c.NGW) {
        const int s = tok % SEQ; const bf16_t* zr = Z + (size_t)tok * NZ + c0;
        const u32x4 cb = *(const u32x4*)(zr + ZCB), cc0 = *(const u32x4*)(zr + ZCC), cu0 = *(const u32x4*)(zr + ZCU);
        u32x4 ccm = (u32x4){0u, 0u, 0u, 0u}, cum = ccm, ccp = ccm, cup = ccm;
        if (s > 0) { ccm = *(const u32x4*)(zr - NZ + ZCC); cum = *(const u32x4*)(zr - NZ + ZCU); }
        if (s < SEQ - 1) { ccp = *(const u32x4*)(zr + NZ + ZCC); cup = *(const u32x4*)(zr + NZ + ZCU); }
        float y[8]; float ss = 0.f;
#pragma unroll
        for (int i = 0; i < 4; ++i) {
            const float hm0 = bf_lo(ccm[i]) * bf_lo(cum[i]), hm1 = bf_hi(ccm[i]) * bf_hi(cum[i]);
            const float h00 = bf_lo(cc0[i]) * bf_lo(cu0[i]), h01 = bf_hi(cc0[i]) * bf_hi(cu0[i]);
            const float hp0 = bf_lo(ccp[i]) * bf_lo(cup[i]), hp1 = bf_hi(ccp[i]) * bf_hi(cup[i]);
            y[2 * i] = bf_lo(cb[i]) * (w0[2 * i] * hm0 + w1[2 * i] * h00 + w2[2 * i] * hp0);
            y[2 * i + 1] = bf_hi(cb[i]) * (w0[2 * i + 1] * hm1 + w1[2 * i + 1] * h01 + w2[2 * i + 1] * hp1);
            ss += y[2 * i] * y[2 * i] + y[2 * i + 1] * y[2 * i + 1]; }
        ss += __shfl_xor(ss, 1); ss += __shfl_xor(ss, 2); ss += __shfl_xor(ss, 4);
        const float rstd = rsqrtf(ss * (1.0f / 64.0f) + EPS);
        u32x4 o;
#pragma unroll
        for (int i = 0; i < 4; ++i) o[i] = cvt_pk_bf16(y[2 * i] * rstd * gn[2 * i], y[2 * i + 1] * rstd * gn[2 * i + 1]);
        *(u32x4*)(Y + (size_t)tok * D + c0) = o;
    }
}
__device__ __forceinline__ void phase_scan(const Ctx& c, const Args& a) {
    const float* UU = (const float*)(a.ws + WS_UU); const float* GG = (const float*)(a.ws + WS_GG); bf16_t* SS = (bf16_t*)(a.ws + WS_SS);
    const int nthreads = c.G * 512;
    for (int idx = blockIdx.x * 512 + c.tid; idx < 2 * 16 * 8192; idx += nthreads) {
        const int dir = idx / (16 * 8192), rem = idx % (16 * 8192), bh = rem / 8192, ed = rem % 8192, d = ed & 63;
        const size_t ubase = (size_t)dir * NUNIT + (size_t)bh * NCH;
        float S = 0.f;
        for (int n0 = 0; n0 < NCH; n0 += 8) {
            float u[8], g[8];
#pragma unroll
            for (int j = 0; j < 8; ++j) { const int n = dir ? (NCH - 1 - (n0 + j)) : (n0 + j); u[j] = UU[(ubase + n) * 8192 + ed]; g[j] = GG[(ubase + n) * 64 + d]; }
#pragma unroll
            for (int j = 0; j < 8; ++j) { const int n = dir ? (NCH - 1 - (n0 + j)) : (n0 + j);
                SS[(ubase + n) * 8192 + ed] = (bf16_t)(cvt_pk_bf16(S, 0.f) & 0xffffu);
                S = __expf(g[j]) * S + u[j]; }
        }
    }
}
__device__ __forceinline__ void phase_gla_c(const Ctx& c, const Args& a) {
    const bf16_t* Z = (const bf16_t*)(a.ws + WS_Z); const bf16_t* SS = (const bf16_t*)(a.ws + WS_SS); bf16_t* Y = (bf16_t*)(a.ws + WS_Y);
    const int fr = c.lane & 15, fq = c.lane >> 4, w = c.wave;
    const f32x4 gnv = *(const f32x4*)(a.in[I_GLAN] + 16 * w + 4 * fq);
    LAS float* red = (LAS float*)(c.lds + L_RED);
    int h_loaded = -1;
    for (int uu = blockIdx.x; uu < NUNIT; uu += c.G) {
        const int h = uu & 3, n = (uu >> 2) & (NCH - 1), b = uu >> 9, unit = (b * GH + h) * NCH + n;
        __syncthreads();
        if (h != h_loaded) { gla_load_w(c, a, h); h_loaded = h; __syncthreads(); }
        gla_prep<false>(c, a, b, h, n, nullptr, nullptr);
        bf16x8 asf[2], asb[2];
#pragma unroll
        for (int ks = 0; ks < 2; ++ks) { asf[ks] = *(const bf16x8*)(SS + ((size_t)unit * 128 + 16 * w + fr) * 64 + 32 * ks + 8 * fq);
                                          asb[ks] = *(const bf16x8*)(SS + ((size_t)(NUNIT + unit) * 128 + 16 * w + fr) * 64 + 32 * ks + 8 * fq); }
        __syncthreads();
        { const int tt = w & 3;
#pragma unroll
          for (int s2 = 0; s2 < 2; ++s2) { const int ss = 2 * (w >> 2) + s2; f32x4 af = (f32x4){0.f, 0.f, 0.f, 0.f}, ab = af;
              if (ss <= tt) {
#pragma unroll
                  for (int ks = 0; ks < 2; ++ks) af = __builtin_amdgcn_mfma_f32_16x16x32_bf16(gfrag(c.lds + L_KF, 16 * ss, ks, fr, fq), gfrag(c.lds + L_QF, 16 * tt, ks, fr, fq), af, 0, 0, 0); }
              if (ss >= tt) {
#pragma unroll
                  for (int ks = 0; ks < 2; ++ks) ab = __builtin_amdgcn_mfma_f32_16x16x32_bf16(gfrag(c.lds + L_KB, 16 * ss, ks, fr, fq), gfrag(c.lds + L_QB, 16 * tt, ks, fr, fq), ab, 0, 0, 0); }
              const int tpos = 16 * tt + fr, s0 = 16 * ss + 4 * fq; float v[4];
#pragma unroll
              for (int i = 0; i < 4; ++i) v[i] = (s0 + i <= tpos) ? af[i] : ab[i];
              u32x2 pk; pk.x = cvt_pk_bf16(v[0], v[1]); pk.y = cvt_pk_bf16(v[2], v[3]);
              *(LAS u32x2*)(c.lds + L_AC + tpos * GS + s0 * 2) = pk; } }
        __syncthreads();
        bf16x8 av[2];
#pragma unroll
        for (int ks = 0; ks < 2; ++ks) av[ks] = gfrag(c.lds + L_VT, 16 * w, ks, fr, fq);
        f32x4 o[4];
#pragma unroll
        for (int tt = 0; tt < 4; ++tt) { f32x4 acc = (f32x4){0.f, 0.f, 0.f, 0.f};
#pragma unroll
            for (int ks = 0; ks < 2; ++ks) { acc = __builtin_amdgcn_mfma_f32_16x16x32_bf16(av[ks], gfrag(c.lds + L_AC, 16 * tt, ks, fr, fq), acc, 0, 0, 0);
                acc = __builtin_amdgcn_mfma_f32_16x16x32_bf16(asf[ks], gfrag(c.lds + L_QF, 16 * tt, ks, fr, fq), acc, 0, 0, 0);
                acc = __builtin_amdgcn_mfma_f32_16x16x32_bf16(asb[ks], gfrag(c.lds + L_QB, 16 * tt, ks, fr, fq), acc, 0, 0, 0); }
            o[tt] = acc;
            float p = (acc[0] * acc[0] + acc[1] * acc[1]) + (acc[2] * acc[2] + acc[3] * acc[3]);
            p += __shfl_xor(p, 16); p += __shfl_xor(p, 32);
            if (fq == 0) red[w * 64 + 16 * tt + fr] = p; }
        __syncthreads();
#pragma unroll
        for (int tt = 0; tt < 4; ++tt) { const int tpos = 16 * tt + fr; float s = 0.f;
#pragma unroll
            for (int ww = 0; ww < 8; ++ww) s += red[ww * 64 + tpos];
            const float rstd = rsqrtf(s * (1.0f / 128.0f) + EPS);
            const size_t row = (size_t)b * SEQ + n * 64 + tpos;
            const u32x2 gr = *(const u32x2*)(Z + row * NZ + ZG + h * 128 + 16 * w + 4 * fq);
            const float g4[4] = {bf_lo(gr.x), bf_hi(gr.x), bf_lo(gr.y), bf_hi(gr.y)}; float y[4];
#pragma unroll
            for (int i = 0; i < 4; ++i) y[i] = o[tt][i] * rstd * gnv[i] * (g4[i] / (1.0f + __expf(-g4[i])));
            u32x2 pk; pk.x = cvt_pk_bf16(y[0], y[1]); pk.y = cvt_pk_bf16(y[2], y[3]);
            *(u32x2*)(Y + row * D + 512 + h * 128 + 16 * w + 4 * fq) = pk; }
    }
}
__device__ __forceinline__ void phase_final(const Ctx& c, const Args& a) {
    const float* gain = a.in[I_FINN];
    for (int m = c.gw; m < T; m += c.NGW) {
        f32x4* xr = (f32x4*)(a.out + (size_t)m * D) + c.lane; const f32x4* gr = (const f32x4*)gain + c.lane;
        f32x4 v[4]; float s = 0.f;
#pragma unroll
        for (int j = 0; j < 4; ++j) { v[j] = xr[64 * j]; s += (v[j][0] * v[j][0] + v[j][1] * v[j][1]) + (v[j][2] * v[j][2] + v[j][3] * v[j][3]); }
        const float rstd = rsqrtf(wave_sum(s) * (1.f / D) + EPS);
#pragma unroll
        for (int j = 0; j < 4; ++j) xr[64 * j] = v[j] * rstd * gr[64 * j];
    }
}

__device__ __forceinline__ int lane_id_opaque() { int l; asm volatile("v_mbcnt_lo_u32_b32 %0, -1, 0\n\tv_mbcnt_hi_u32_b32 %0, -1, %0" : "=v"(l)); return l; }
typedef __attribute__((address_space(4))) const Args* KArgP;
__device__ __forceinline__ Args load_args() {
    Args a{};
#if defined(__HIP_DEVICE_COMPILE__)
    KArgP p = (KArgP)__builtin_amdgcn_kernarg_segment_ptr(); asm volatile("" : "+s"(p));
#pragma unroll
    for (int i = 0; i < 21; ++i) a.in[i] = p->in[i];
    a.out = p->out; a.ws = p->ws; a.ph_lo = p->ph_lo; a.ph_hi = p->ph_hi;
#endif
    return a;
}
__global__ void __launch_bounds__(512, 2) mk_fwd(Args args_unused) {
    extern __shared__ __attribute__((aligned(16))) unsigned char lds_raw[];
    const int wave0 = __builtin_amdgcn_readfirstlane(threadIdx.x >> 6);
#define MAKE_CTX() Ctx c; c.lds = (LAS unsigned char*)lds_raw; c.wave = wave0; c.lane = lane_id_opaque(); c.tid = c.wave * 64 + c.lane; c.G = gridDim.x; c.gw = blockIdx.x * 8 + c.wave; c.NGW = c.G * 8
    int lo, hi; { const Args a0 = load_args(); lo = a0.ph_lo; hi = a0.ph_hi; }
#if MK_MODE == 1
#define GRID_BAR() cg::this_grid().sync()
#else
#define GRID_BAR() do { } while (0)
#endif
#ifndef PHASE_MASK
#define PHASE_MASK 0x1fff
#endif
#define IN(k) (((PHASE_MASK >> (k)) & 1) && lo <= (k) && (k) < hi)
#define SEAM(k) do { if (IN(k) && IN((k) + 1)) { GRID_BAR(); } } while (0)
    using namespace pg8;

    if (IN(0)) { MAKE_CTX(); const Args args = load_args(); phase_prologue(c, args); SEAM(0); }
    if (IN(1)) { MAKE_CTX(); const Args args = load_args(); unsigned char* ws = args.ws; bf16_t* XN = (bf16_t*)(ws + WS_XN);
        { ProbPlain g{XN, (const bf16_t*)(ws + WS_WIN), D, D, D}; StaticOrder S; S.init(T, NZP, c.G, (int)blockIdx.x);
          EpiZ E{(bf16_t*)(ws + WS_Z), (float*)(ws + WS_LR)};
          gemm_phase<EpiZ, ProbPlain, StaticOrder, true>(c.lds, c.tid, c.wave, g, S, E); }
        __syncthreads();
        { ProbPlain g{(const bf16_t*)(ws + WS_MN), (const bf16_t*)(ws + WS_WXKV), D, D, D}; StaticOrder S; S.init(MROWS, 2 * D, c.G, (int)blockIdx.x);
          EpiKV E{(bf16_t*)(ws + WS_KMEM), (bf16_t*)(ws + WS_VT)};
          gemm_phase<EpiKV, ProbPlain, StaticOrder, true>(c.lds, c.tid, c.wave, g, S, E); }
        SEAM(1);
    }
    if (IN(2)) { MAKE_CTX(); const Args args = load_args();
#ifndef NO_GLA_A
        phase_gla_a(c, args);
#endif
#ifndef NO_CONV
        phase_conv(c, args);
#endif
        SEAM(2); }
    if (IN(3)) { MAKE_CTX(); const Args args = load_args(); phase_scan(c, args); SEAM(3); }
    if (IN(4)) { MAKE_CTX(); const Args args = load_args(); phase_gla_c(c, args); SEAM(4); }
    if (IN(5)) { MAKE_CTX(); const Args args = load_args(); unsigned char* ws = args.ws; bf16_t* XN = (bf16_t*)(ws + WS_XN); float* SSQ = (float*)(ws + WS_SSQ); (void)XN; (void)SSQ;
        ProbPlain g{(const bf16_t*)(ws + WS_Y), (const bf16_t*)(ws + WS_WOUT), D, D, D}; StaticOrder S; S.init(T, D, c.G, (int)blockIdx.x);
        EpiRes<true> E{args.in[I_X], args.out, args.in[I_XAN], XN, SSQ};
        gemm_phase<EpiRes<true>, ProbPlain, StaticOrder, true>(c.lds, c.tid, c.wave, g, S, E);
        SEAM(5);
    }
    if (IN(6)) { MAKE_CTX(); const Args args = load_args(); unsigned char* ws = args.ws; bf16_t* XN = (bf16_t*)(ws + WS_XN); float* SSQ = (float*)(ws + WS_SSQ); (void)XN; (void)SSQ;
        ProbPlain g{XN, (const bf16_t*)(ws + WS_WXQ), D, D, D}; StaticOrder S; S.init(T, D, c.G, (int)blockIdx.x);
        EpiScale<0> E{(bf16_t*)(ws + WS_HQ), D, SSQ, 1.0f / 16.0f};
        gemm_phase<EpiScale<0>, ProbPlain, StaticOrder, true>(c.lds, c.tid, c.wave, g, S, E);
        SEAM(6);
    }
    if (IN(7)) { MAKE_CTX(); const Args args = load_args(); unsigned char* ws = args.ws; bf16_t* XN = (bf16_t*)(ws + WS_XN); float* SSQ = (float*)(ws + WS_SSQ); (void)XN; (void)SSQ;
        ProbQK g{(const bf16_t*)(ws + WS_HQ), (const bf16_t*)(ws + WS_KMEM), D, D, 256}; StaticOrder S; S.init(T, D, c.G, (int)blockIdx.x);
        EpiSoftmax E{(bf16_t*)(ws + WS_P), D, (LAS float*)(c.lds + EPI_LDS_OFF)};
        gemm_phase<EpiSoftmax, ProbQK, StaticOrder, true>(c.lds, c.tid, c.wave, g, S, E);
        SEAM(7);
    }
    if (IN(8)) { MAKE_CTX(); const Args args = load_args(); unsigned char* ws = args.ws; bf16_t* XN = (bf16_t*)(ws + WS_XN); float* SSQ = (float*)(ws + WS_SSQ); (void)XN; (void)SSQ;
        ProbPV g{(const bf16_t*)(ws + WS_P), (const bf16_t*)(ws + WS_VT), D, 256, 256}; StaticOrder S; S.init(T, D, c.G, (int)blockIdx.x);
        EpiBf16 E{(bf16_t*)(ws + WS_O), D};
        gemm_phase<EpiBf16, ProbPV, StaticOrder, true>(c.lds, c.tid, c.wave, g, S, E);
        SEAM(8);
    }
    if (IN(9)) { MAKE_CTX(); const Args args = load_args(); unsigned char* ws = args.ws; bf16_t* XN = (bf16_t*)(ws + WS_XN); float* SSQ = (float*)(ws + WS_SSQ); (void)XN; (void)SSQ;
        ProbPlain g{(const bf16_t*)(ws + WS_O), (const bf16_t*)(ws + WS_WXO), D, D, D}; StaticOrder S; S.init(T, D, c.G, (int)blockIdx.x);
        EpiRes<true> E{args.out, (float*)(ws + WS_RB), args.in[I_MLPN], XN, SSQ};
        gemm_phase<EpiRes<true>, ProbPlain, StaticOrder, true>(c.lds, c.tid, c.wave, g, S, E);
        SEAM(9);
    }
    if (IN(10)) { MAKE_CTX(); const Args args = load_args(); unsigned char* ws = args.ws; bf16_t* XN = (bf16_t*)(ws + WS_XN); float* SSQ = (float*)(ws + WS_SSQ); (void)XN; (void)SSQ;
        ProbPlain g{XN, (const bf16_t*)(ws + WS_WUP), D, D, D}; StaticOrder S; S.init(T, FF, c.G, (int)blockIdx.x);
        EpiScale<1> E{(bf16_t*)(ws + WS_U), FF, SSQ, 1.0f};
        gemm_phase<EpiScale<1>, ProbPlain, StaticOrder, true>(c.lds, c.tid, c.wave, g, S, E);
        SEAM(10);
    }
    if (IN(11)) { MAKE_CTX(); const Args args = load_args(); unsigned char* ws = args.ws; bf16_t* XN = (bf16_t*)(ws + WS_XN); float* SSQ = (float*)(ws + WS_SSQ); (void)XN; (void)SSQ;
        ProbPlain g{(const bf16_t*)(ws + WS_U), (const bf16_t*)(ws + WS_WDN), FF, FF, FF}; StaticOrder S; S.init(T, D, c.G, (int)blockIdx.x);
        EpiRes<false> E{(const float*)(ws + WS_RB), args.out, nullptr, nullptr, nullptr};
        gemm_phase<EpiRes<false>, ProbPlain, StaticOrder, true>(c.lds, c.tid, c.wave, g, S, E);
        SEAM(11);
    }
    if (IN(12)) { MAKE_CTX(); const Args args = load_args(); phase_final(c, args); }
#undef IN
#undef SEAM
#undef GRID_BAR
}

extern "C" void kernel_launch(void* const* d_in, const int* in_sizes, int n_in, void* d_out, int out_size, void* d_ws, size_t ws_size, hipStream_t stream) {
    static int grid = 0;
    if (grid == 0) {
        if (n_in != 21 || in_sizes[0] != T * D || out_size != T * D || ws_size < WS_END) {
            fprintf(stderr, "kernel_launch: unexpected shapes: n_in %d in0 %d out %d ws %zu (need %zu); nothing launched\n", n_in, n_in > 0 ? in_sizes[0] : -1, out_size, ws_size, (size_t)WS_END); grid = -1; return; }
        int dev = 0, cus = 0, per_cu = 0;
        if (hipGetDevice(&dev) != hipSuccess || hipDeviceGetAttribute(&cus, hipDeviceAttributeMultiprocessorCount, dev) != hipSuccess) { fprintf(stderr, "kernel_launch: device query failed\n"); grid = -1; return; }
        if (hipFuncSetAttribute((const void*)mk_fwd, hipFuncAttributeMaxDynamicSharedMemorySize, LDS_BYTES) != hipSuccess) { fprintf(stderr, "kernel_launch: hipFuncSetAttribute failed\n"); grid = -1; return; }
        if (hipOccupancyMaxActiveBlocksPerMultiprocessor(&per_cu, (const void*)mk_fwd, 512, LDS_BYTES) != hipSuccess || per_cu < 1) { fprintf(stderr, "kernel_launch: occupancy query says %d blocks per CU\n", per_cu); (void)hipGetLastError(); grid = -1; return; }
        grid = cus * (per_cu < 1 ? 1 : 1);
        fprintf(stderr, "kernel_launch: %d CUs, occupancy query %d per CU, grid %d\n", cus, per_cu, grid);
    }
    if (grid < 0) return;
    Args a{};
    for (int i = 0; i < 21; ++i) a.in[i] = (const float*)d_in[i];
    a.out = (float*)d_out; a.ws = (unsigned char*)d_ws;
#if MK_MODE == 0
    for (int p = 0; p < N_PHASES; ++p) { a.ph_lo = p; a.ph_hi = p + 1; hipLaunchKernelGGL(mk_fwd, dim3(grid), dim3(512), LDS_BYTES, stream, a); }
#else
    a.ph_lo = 0; a.ph_hi = N_PHASES;
    void* kargs[] = {&a};
    hipError_t e = hipLaunchCooperativeKernel((const void*)mk_fwd, dim3(grid), dim3(512), kargs, LDS_BYTES, stream);
    if (e != hipSuccess) fprintf(stderr, "kernel_launch: cooperative launch failed: %s (grid %d)\n", hipGetErrorString(e), grid);
#endif
}
```

```cpp
#include <hip/hip_runtime.h>
#include <hip/hip_cooperative_groups.h>
#include <cstdio>
#include <cstdint>
namespace cg = cooperative_groups;

#ifndef MK_MODE
#define MK_MODE 2
#endif
#ifndef MK_CG_FIRST
#define MK_CG_FIRST 0
#endif

#define LAS __attribute__((address_space(3)))
typedef unsigned short bf16_t;
typedef short bf16x8 __attribute__((ext_vector_type(8)));
typedef float f32x4 __attribute__((ext_vector_type(4)));
typedef float f32x2 __attribute__((ext_vector_type(2)));
typedef unsigned u32x4 __attribute__((ext_vector_type(4)));
typedef unsigned u32x2 __attribute__((ext_vector_type(2)));

constexpr int BATCH = 4, SEQ = 8192, T = BATCH * SEQ, D = 1024, NMEM = 256, MROWS = BATCH * NMEM;
constexpr int WIN = 3104, NZ = 3072, NZP = 3328, FF = 4096;
constexpr int ZCB = 0, ZCC = 512, ZCU = 1024, ZQ = 1536, ZK = 1792, ZV = 2048, ZG = 2560;
constexpr int GH = 4, NCH = SEQ / 64, NUNIT = BATCH * GH * NCH;
constexpr float EPS = 1e-6f;

constexpr size_t MiB = 1u << 20;
constexpr size_t WS_CTL = 0;
constexpr size_t WS_WIN = 1 * MiB;
constexpr size_t WS_WOUT = 8 * MiB;
constexpr size_t WS_WXQ = 10 * MiB;
constexpr size_t WS_WXKV = 12 * MiB;
constexpr size_t WS_WXO = 16 * MiB;
constexpr size_t WS_WUP = 18 * MiB;
constexpr size_t WS_WDN = 26 * MiB;
constexpr size_t WS_MN = 34 * MiB;
constexpr size_t WS_KMEM = 36 * MiB;
constexpr size_t WS_VT = 38 * MiB;
constexpr size_t WS_SSQ = 40 * MiB;
constexpr size_t WS_LR = 42 * MiB;
constexpr size_t WS_GG = 46 * MiB;
constexpr size_t WS_XN = 48 * MiB;
constexpr size_t WS_SS = 48 * MiB;
constexpr size_t WS_Y = 112 * MiB;
constexpr size_t WS_HQ = 112 * MiB;
constexpr size_t WS_Z = 176 * MiB;
constexpr size_t WS_P = 176 * MiB;
constexpr size_t WS_O = 240 * MiB;
constexpr size_t WS_UU = 368 * MiB;
constexpr size_t WS_RB = 368 * MiB;
constexpr size_t WS_U = 112 * MiB;
constexpr size_t WS_END = 496 * MiB;

constexpr int LDS_BYTES = 147456;
constexpr int RING_BYTES = 131072;
constexpr int EPI_LDS_OFF = RING_BYTES;

__device__ __forceinline__ unsigned cvt_pk_bf16(float lo, float hi) { unsigned r; asm volatile("v_cvt_pk_bf16_f32 %0, %1, %2" : "=v"(r) : "v"(lo), "v"(hi)); return r; }
__device__ __forceinline__ float bf_lo(unsigned x) { return __uint_as_float(x << 16); }
__device__ __forceinline__ float bf_hi(unsigned x) { return __uint_as_float(x & 0xffff0000u); }
__device__ __forceinline__ float wave_sum(float v) {
#pragma unroll
    for (int o = 1; o < 64; o <<= 1) v += __shfl_xor(v, o);
    return v;
}
#define LDS_WAIT() asm volatile("s_waitcnt lgkmcnt(0)" ::: "memory")
#define VM_WAIT() asm volatile("s_waitcnt vmcnt(0)" ::: "memory")

namespace pg8 {
constexpr int BM = 256, BK = 64, HALF = 128, HTB = HALF * BK * 2, STAGE_BYTES = 8 * HTB, NXCD = 8, WGM = 8;
__host__ __device__ __forceinline__ int lds_byte(int r, int c) { const int st = (r >> 4) * 2 + (c >> 5), rr = r & 15, cc = c & 31, ob = rr * 64 + cc * 2; return st * 1024 + (ob ^ (((ob >> 9) & 1) << 5)); }
__host__ __device__ __forceinline__ void stage_rc(int b, int& R, int& C) { const int st = b / 1024, sb = b % 1024, swz = sb ^ (((sb >> 9) & 1) << 5); R = (st >> 1) * 16 + swz / 64; C = (st & 1) * 32 + (swz % 64) / 2; }
__host__ __device__ __forceinline__ int perm32(int rho) { const int n = rho >> 4, i = rho & 15; return 8 * (i >> 2) + 4 * n + (i & 3); }

struct Unit { int pm, pn; };

struct StaticOrder {
    int nM, nN, nwg, G, c;
    __host__ __device__ void init(int M, int N, int G_, int c_) { nM = M / BM; nN = N / BM; nwg = nM * nN; G = G_; c = c_; }
    __host__ __device__ bool next(int i, Unit& u) const {
        const long L = (long)i * G + c; if (L >= nwg) return false;
        int wgid = (int)L; { const int q = nwg / NXCD, r = nwg % NXCD, xcd = wgid % NXCD, off = wgid / NXCD; wgid = (xcd < r ? xcd * (q + 1) : r * (q + 1) + (xcd - r) * q) + off; }
        const int nig = WGM * nN, gid = wgid / nig, fm = gid * WGM, gsz = (nM - fm) < WGM ? (nM - fm) : WGM;
        u.pm = fm + ((wgid % nig) % gsz); u.pn = (wgid % nig) / gsz; return true;
    }
};

struct ProbPlain { const bf16_t* A; const bf16_t* Bt; int lda, ldb, K;
    __device__ __forceinline__ const char* a_base(const Unit& u) const { return (const char*)(A + (size_t)u.pm * BM * lda); }
    __device__ __forceinline__ const char* b_base(const Unit& u) const { return (const char*)(Bt + (size_t)u.pn * BM * ldb); } };
struct ProbQK { const bf16_t* A; const bf16_t* Bt; int lda, ldb, K;
    __device__ __forceinline__ const char* a_base(const Unit& u) const { return (const char*)(A + (size_t)u.pm * BM * lda + u.pn * 256); }
    __device__ __forceinline__ const char* b_base(const Unit& u) const { return (const char*)(Bt + (size_t)(u.pm >> 5) * 256 * ldb + u.pn * 256); } };
struct ProbPV { const bf16_t* A; const bf16_t* Bt; int lda, ldb, K;
    __device__ __forceinline__ const char* a_base(const Unit& u) const { return (const char*)(A + (size_t)u.pm * BM * lda + u.pn * 256); }
    __device__ __forceinline__ const char* b_base(const Unit& u) const { return (const char*)(Bt + (size_t)((u.pm >> 5) * 4 + u.pn) * 256 * ldb); } };

typedef f32x4 Acc[2][2][4][2];

__device__ __forceinline__ void store8_bf16(bf16_t* p, f32x4 v0, f32x4 v1) {
    u32x4 w; w.x = cvt_pk_bf16(v0[0], v0[1]); w.y = cvt_pk_bf16(v0[2], v0[3]); w.z = cvt_pk_bf16(v1[0], v1[1]); w.w = cvt_pk_bf16(v1[2], v1[3]);
    *(u32x4*)p = w;
}

struct EpiBf16 { static constexpr bool PERM = true; bf16_t* O; int ldc;
    __device__ __forceinline__ void operator()(Acc& acc, const Unit& u, int wr, int wc, int fr, int fq) const {
        const int row0 = u.pm * BM + wr * 64 + fr, col0 = u.pn * BM + wc * 32 + 8 * fq;
#pragma unroll
        for (int ai = 0; ai < 2; ++ai)
#pragma unroll
            for (int m = 0; m < 4; ++m) { bf16_t* rowp = O + (size_t)(row0 + ai * HALF + m * 16) * ldc + col0;
#pragma unroll
                for (int bj = 0; bj < 2; ++bj) store8_bf16(rowp + bj * HALF, acc[ai][bj][m][0], acc[ai][bj][m][1]); }
    }
};
struct EpiZ { static constexpr bool PERM = true; bf16_t* Z; float* LR;
    __device__ __forceinline__ void operator()(Acc& acc, const Unit& u, int wr, int wc, int fr, int fq) const {
        const int row0 = u.pm * BM + wr * 64 + fr;
        if (u.pn < 12) {
            const int col0 = u.pn * BM + wc * 32 + 8 * fq;
#pragma unroll
            for (int ai = 0; ai < 2; ++ai)
#pragma unroll
                for (int m = 0; m < 4; ++m) { bf16_t* rowp = Z + (size_t)(row0 + ai * HALF + m * 16) * NZ + col0;
#pragma unroll
                    for (int bj = 0; bj < 2; ++bj) store8_bf16(rowp + bj * HALF, acc[ai][bj][m][0], acc[ai][bj][m][1]); }
        } else if (wc == 0) {
#pragma unroll
            for (int ai = 0; ai < 2; ++ai)
#pragma unroll
                for (int m = 0; m < 4; ++m) { float* p = LR + (size_t)(row0 + ai * HALF + m * 16) * 32 + 8 * fq;
                    *(f32x4*)p = acc[ai][0][m][0]; *(f32x4*)(p + 4) = acc[ai][0][m][1]; }
        }
    }
};
struct EpiKV { static constexpr bool PERM = true; bf16_t* Kmem; bf16_t* Vt;
    __device__ __forceinline__ void operator()(Acc& acc, const Unit& u, int wr, int wc, int fr, int fq) const {
        if (u.pn < 4) {
            const int row0 = u.pm * BM + wr * 64 + fr, col0 = u.pn * BM + wc * 32 + 8 * fq;
#pragma unroll
            for (int ai = 0; ai < 2; ++ai)
#pragma unroll
                for (int m = 0; m < 4; ++m) { bf16_t* rowp = Kmem + (size_t)(row0 + ai * HALF + m * 16) * 1024 + col0;
#pragma unroll
                    for (int bj = 0; bj < 2; ++bj) store8_bf16(rowp + bj * HALF, acc[ai][bj][m][0], acc[ai][bj][m][1]); }
        } else {
            bf16_t* vb = Vt + (size_t)(u.pm * 4 + (u.pn - 4)) * 256 * 256;
#pragma unroll
            for (int ai = 0; ai < 2; ++ai)
#pragma unroll
                for (int m = 0; m < 4; ++m) { const int key = ai * HALF + wr * 64 + m * 16 + fr;
#pragma unroll
                    for (int bj = 0; bj < 2; ++bj) { const int dim0 = bj * HALF + wc * 32 + 8 * fq;
#pragma unroll
                        for (int n = 0; n < 2; ++n) { const f32x4 v = acc[ai][bj][m][n]; const unsigned a = cvt_pk_bf16(v[0], v[1]), b = cvt_pk_bf16(v[2], v[3]);
                            bf16_t* q = vb + (size_t)(dim0 + 4 * n) * 256 + key;
                            q[0] = (bf16_t)(a & 0xffffu); q[256] = (bf16_t)(a >> 16); q[512] = (bf16_t)(b & 0xffffu); q[768] = (bf16_t)(b >> 16); } } }
        }
    }
};
template <bool NORM> struct EpiRes { static constexpr bool PERM = false; const float* base; float* out; const float* gain; bf16_t* XN; float* SSQ;
    __device__ __forceinline__ void operator()(Acc& acc, const Unit& u, int wr, int wc, int fr, int fq) const {
        const int row0 = u.pm * BM + wr * 64 + fr, col0 = u.pn * BM + wc * 32 + 4 * fq;
        f32x4 gv[2][2];
        if (NORM) {
#pragma unroll
            for (int bj = 0; bj < 2; ++bj)
#pragma unroll
                for (int n = 0; n < 2; ++n) gv[bj][n] = *(const f32x4*)(gain + col0 + bj * HALF + n * 16);
        }
#pragma unroll
        for (int ai = 0; ai < 2; ++ai)
#pragma unroll
            for (int m = 0; m < 4; ++m) { const int row = row0 + ai * HALF + m * 16; const size_t off = (size_t)row * D + col0; float ss = 0.f;
#pragma unroll
                for (int bj = 0; bj < 2; ++bj)
#pragma unroll
                    for (int n = 0; n < 2; ++n) { const f32x4 v = *(const f32x4*)(base + off + bj * HALF + n * 16) + acc[ai][bj][m][n];
                        *(f32x4*)(out + off + bj * HALF + n * 16) = v;
                        if (NORM) { ss += (v[0] * v[0] + v[1] * v[1]) + (v[2] * v[2] + v[3] * v[3]); const f32x4 w = v * gv[bj][n];
                            u32x2 pk; pk.x = cvt_pk_bf16(w[0], w[1]); pk.y = cvt_pk_bf16(w[2], w[3]); *(u32x2*)(XN + off + bj * HALF + n * 16) = pk; } }
                if (NORM) { ss += __shfl_xor(ss, 16); ss += __shfl_xor(ss, 32); if (fq == 0) SSQ[(size_t)row * 16 + u.pn * 4 + wc] = ss; }
                if (m & 1) asm volatile("" ::: "memory"); }
    }
};
template <int ACT> struct EpiScale { static constexpr bool PERM = true; bf16_t* O; int ldc; const float* SSQ; float post;
    __device__ __forceinline__ void operator()(Acc& acc, const Unit& u, int wr, int wc, int fr, int fq) const {
        const int row0 = u.pm * BM + wr * 64 + fr, col0 = u.pn * BM + wc * 32 + 8 * fq;
#pragma unroll
        for (int ai = 0; ai < 2; ++ai)
#pragma unroll
            for (int m = 0; m < 4; ++m) { const int row = row0 + ai * HALF + m * 16; const f32x4* sp = (const f32x4*)(SSQ + (size_t)row * 16);
                const f32x4 s4 = (sp[0] + sp[1]) + (sp[2] + sp[3]); const float s = (s4[0] + s4[1]) + (s4[2] + s4[3]);
                const float rs = rsqrtf(s * (1.0f / D) + EPS) * post; bf16_t* rowp = O + (size_t)row * ldc + col0;
#pragma unroll
                for (int bj = 0; bj < 2; ++bj) { f32x4 v0 = acc[ai][bj][m][0] * rs, v1 = acc[ai][bj][m][1] * rs;
                    if (ACT == 1) {
#pragma unroll
                        for (int i = 0; i < 4; ++i) { const float a = fmaxf(v0[i], 0.f), b = fmaxf(v1[i], 0.f); v0[i] = a * a; v1[i] = b * b; } }
                    store8_bf16(rowp + bj * HALF, v0, v1); } }
    }
};
struct EpiSoftmax { static constexpr bool PERM = true; bf16_t* P; int ldc; LAS float* red;
    __device__ __forceinline__ void operator()(Acc& acc, const Unit& u, int wr, int wc, int fr, int fq) const {
        LAS float* red0 = red; LAS float* red1 = red + 1024;
#pragma unroll
        for (int ai = 0; ai < 2; ++ai)
#pragma unroll
            for (int m = 0; m < 4; ++m) { float mx = -3.0e38f;
#pragma unroll
                for (int bj = 0; bj < 2; ++bj)
#pragma unroll
                    for (int n = 0; n < 2; ++n) { const f32x4 v = acc[ai][bj][m][n]; mx = fmaxf(mx, fmaxf(fmaxf(v[0], v[1]), fmaxf(v[2], v[3]))); }
                mx = fmaxf(mx, __shfl_xor(mx, 16)); mx = fmaxf(mx, __shfl_xor(mx, 32));
                if (fq == 0) red0[(ai * HALF + wr * 64 + m * 16 + fr) * 4 + wc] = mx; }
        LDS_WAIT(); __builtin_amdgcn_s_barrier(); asm volatile("" ::: "memory");
#pragma unroll
        for (int ai = 0; ai < 2; ++ai)
#pragma unroll
            for (int m = 0; m < 4; ++m) { const int r = ai * HALF + wr * 64 + m * 16 + fr; const f32x4 q = *(const LAS f32x4*)(red0 + r * 4);
                const float M = fmaxf(fmaxf(q[0], q[1]), fmaxf(q[2], q[3])); float s = 0.f;
#pragma unroll
                for (int bj = 0; bj < 2; ++bj)
#pragma unroll
                    for (int n = 0; n < 2; ++n) { f32x4 v = acc[ai][bj][m][n];
#pragma unroll
                        for (int i = 0; i < 4; ++i) { v[i] = __expf(v[i] - M); s += v[i]; }
                        acc[ai][bj][m][n] = v; }
                s += __shfl_xor(s, 16); s += __shfl_xor(s, 32);
                if (fq == 0) red1[r * 4 + wc] = s; }
        LDS_WAIT(); __builtin_amdgcn_s_barrier(); asm volatile("" ::: "memory");
        const int row0 = u.pm * BM + wr * 64 + fr, col0 = u.pn * BM + wc * 32 + 8 * fq;
#pragma unroll
        for (int ai = 0; ai < 2; ++ai)
#pragma unroll
            for (int m = 0; m < 4; ++m) { const int r = ai * HALF + wr * 64 + m * 16 + fr; const f32x4 q = *(const LAS f32x4*)(red1 + r * 4);
                const float inv = 1.0f / ((q[0] + q[1]) + (q[2] + q[3])); bf16_t* rowp = P + (size_t)(row0 + ai * HALF + m * 16) * ldc + col0;
#pragma unroll
                for (int bj = 0; bj < 2; ++bj) store8_bf16(rowp + bj * HALF, acc[ai][bj][m][0] * inv, acc[ai][bj][m][1] * inv); }
    }
};

template <class Epi, class Prob, class Sched, bool ALIGN_EPI>
__device__ __forceinline__ void gemm_phase(LAS unsigned char* lds, int tid, int wid, const Prob g, const Sched& S, const Epi& E) {
    const int lane = tid & 63, wr = wid >> 2, wc = wid & 3, fr = lane & 15, fq = lane >> 4;
    const int K = g.K, nt = K / BK;
    unsigned voffA[2], voffB[2];
#pragma unroll
    for (int i = 0; i < 2; ++i) { int R, C; stage_rc(tid * 16 + i * 8192, R, C); const int Rb = Epi::PERM ? ((R & ~31) + perm32(R & 31)) : R;
        voffA[i] = (unsigned)(R * g.lda + C) * 2u; voffB[i] = (unsigned)(Rb * g.ldb + C) * 2u; }
    const size_t kstep = (size_t)(BK * 2);
    const size_t hstepA = (size_t)HALF * g.lda * 2, hstepB = (size_t)HALF * g.ldb * 2;
    const unsigned ldsw = (unsigned)wid * 1024u;
    const int aoff = lds_byte(wr * 64 + fr, fq * 8), boff = lds_byte(wc * 32 + fr, fq * 8);
#define PG8_SA(b, h) (((b) * 2 + (h)) * HTB)
#define PG8_SB(b, h) ((4 + (b) * 2 + (h)) * HTB)
#define PG8_STAGE(bufoff, gbase, voff) do { _Pragma("unroll") for (int _i = 0; _i < 2; ++_i) \
        __builtin_amdgcn_global_load_lds((const unsigned*)((const char*)(gbase) + (voff)[_i]), (LAS unsigned*)(lds + (bufoff) + ldsw + _i * 8192), 16, 0, 0); } while (0)
#define PG8_LDA(dst, b, h) do { _Pragma("unroll") for (int m = 0; m < 4; ++m) _Pragma("unroll") for (int k = 0; k < 2; ++k) dst[m][k] = *(const LAS bf16x8*)(lds + PG8_SA(b, h) + aoff + m * 2048 + k * 1024); } while (0)
#define PG8_LDB(dst, b, h) do { _Pragma("unroll") for (int n = 0; n < 2; ++n) _Pragma("unroll") for (int k = 0; k < 2; ++k) dst[n][k] = *(const LAS bf16x8*)(lds + PG8_SB(b, h) + boff + n * 2048 + k * 1024); } while (0)
#define PG8_MMA(ai, bj, At, Bt) do { __builtin_amdgcn_s_setprio(1); _Pragma("unroll") for (int m = 0; m < 4; ++m) _Pragma("unroll") for (int n = 0; n < 2; ++n) _Pragma("unroll") for (int k = 0; k < 2; ++k) \
        acc[ai][bj][m][n] = __builtin_amdgcn_mfma_f32_16x16x32_bf16(Bt[n][k], At[m][k], acc[ai][bj][m][n], 0, 0, 0); __builtin_amdgcn_s_setprio(0); } while (0)
#define PG8_WAIT_V(n) asm volatile("s_waitcnt vmcnt(" #n ")" ::: "memory")
#define PG8_WAIT_L(n) asm volatile("s_waitcnt lgkmcnt(" #n ")" ::: "memory")
#define PG8_BAR __builtin_amdgcn_s_barrier()
#define PG8_SCHED __builtin_amdgcn_sched_barrier(0)
    Unit cur, nxt; int ui = 0;
    if (!S.next(0, cur)) return;
    Acc acc;
#pragma unroll
    for (int a = 0; a < 2; ++a)
#pragma unroll
        for (int b = 0; b < 2; ++b)
#pragma unroll
            for (int m = 0; m < 4; ++m)
#pragma unroll
                for (int n = 0; n < 2; ++n) acc[a][b][m][n] = (f32x4){0.f, 0.f, 0.f, 0.f};
    bf16x8 At[4][2], B0[2][2], B1[2][2];
    const char* cA = g.a_base(cur); const char* cB = g.b_base(cur);
    PG8_STAGE(PG8_SB(0, 0), cB, voffB); PG8_STAGE(PG8_SB(0, 1), cB + hstepB, voffB); PG8_STAGE(PG8_SA(0, 0), cA, voffA); PG8_STAGE(PG8_SA(0, 1), cA + hstepA, voffA);
    if (wr == 1) PG8_BAR;
    PG8_WAIT_V(2); PG8_BAR;
    PG8_STAGE(PG8_SB(1, 0), cB + kstep, voffB); PG8_STAGE(PG8_SA(1, 0), cA + kstep, voffA); PG8_STAGE(PG8_SB(1, 1), cB + hstepB + kstep, voffB);
    PG8_WAIT_V(6); PG8_BAR;
    for (;;) {
        const bool has_next = S.next(ui + 1, nxt);
        const char* nA = has_next ? g.a_base(nxt) : cA; const char* nB = has_next ? g.b_base(nxt) : cB;
#pragma nounroll
        for (int t = 0; t < nt; t += 2) {
            const bool last = (t == nt - 2);
            const char* a1 = cA + (size_t)(t + 1) * kstep;
            const char* a2 = last ? nA : cA + (size_t)(t + 2) * kstep; const char* b2 = last ? nB : cB + (size_t)(t + 2) * kstep;
            const char* a3 = a2 + kstep; const char* b3 = b2 + kstep;
            PG8_LDB(B0, 0, 0); PG8_LDB(B1, 0, 1); PG8_SCHED; PG8_LDA(At, 0, 0); PG8_STAGE(PG8_SA(1, 1), a1 + hstepA, voffA);
            PG8_WAIT_V(8); PG8_WAIT_L(0); PG8_BAR; PG8_MMA(0, 0, At, B0); PG8_MMA(0, 1, At, B1); PG8_BAR; PG8_SCHED;
            PG8_LDA(At, 0, 1); PG8_STAGE(PG8_SB(0, 0), b2, voffB); PG8_STAGE(PG8_SB(0, 1), b2 + hstepB, voffB); PG8_STAGE(PG8_SA(0, 0), a2, voffA);
            PG8_WAIT_V(8); PG8_WAIT_L(0); PG8_BAR; PG8_MMA(1, 0, At, B0); PG8_MMA(1, 1, At, B1); PG8_BAR; PG8_SCHED;
            PG8_LDB(B0, 1, 0); PG8_LDB(B1, 1, 1); PG8_SCHED; PG8_LDA(At, 1, 0); PG8_STAGE(PG8_SA(0, 1), a2 + hstepA, voffA);
            PG8_WAIT_V(8); PG8_WAIT_L(0); PG8_BAR; PG8_MMA(0, 0, At, B0); PG8_MMA(0, 1, At, B1); PG8_BAR; PG8_SCHED;
            PG8_LDA(At, 1, 1); PG8_STAGE(PG8_SB(1, 0), b3, voffB); PG8_STAGE(PG8_SB(1, 1), b3 + hstepB, voffB); PG8_STAGE(PG8_SA(1, 0), a3, voffA);
            PG8_WAIT_V(8); PG8_WAIT_L(0); PG8_BAR; PG8_MMA(1, 0, At, B0); PG8_MMA(1, 1, At, B1); PG8_BAR; PG8_SCHED;
        }
        if constexpr (ALIGN_EPI) { if (wr == 0) PG8_BAR; }
        E(acc, cur, wr, wc, fr, fq);
        if (!has_next) break;
#pragma unroll
        for (int a = 0; a < 2; ++a)
#pragma unroll
            for (int b = 0; b < 2; ++b)
#pragma unroll
                for (int m = 0; m < 4; ++m)
#pragma unroll
                    for (int n = 0; n < 2; ++n) acc[a][b][m][n] = (f32x4){0.f, 0.f, 0.f, 0.f};
        cur = nxt; cA = nA; cB = nB; ++ui;
        if constexpr (ALIGN_EPI) { if (wr == 1) PG8_BAR; }
    }
    PG8_WAIT_V(0);
    if constexpr (!ALIGN_EPI) { if (wr == 0) PG8_BAR; }
    PG8_BAR;
#undef PG8_SA
#undef PG8_SB
#undef PG8_STAGE
#undef PG8_LDA
#undef PG8_LDB
#undef PG8_MMA
#undef PG8_WAIT_V
#undef PG8_WAIT_L
#undef PG8_BAR
#undef PG8_SCHED
}
}

struct Args { const float* in[21]; float* out; unsigned char* ws; int ph_lo, ph_hi; };
enum { I_X = 0, I_MEM, I_MIXN, I_WIN, I_CONVW, I_CONVN, I_WAF, I_BAF, I_WAB, I_BAB, I_GLAN, I_WOUT, I_XAN, I_MEMN, I_WXQ, I_WXKV, I_WXO, I_MLPN, I_WUP, I_WDN, I_FINN };
constexpr int N_PHASES = 13;

struct Ctx { LAS unsigned char* lds; int tid, lane, wave, gw, NGW, G; };

__device__ __forceinline__ void p0_transpose_item(const float* W, int K, int N, bf16_t* WT, LAS float* scr, int item, int lane) {
    const int nblk = N / 32, kb = item / nblk, nb = item % nblk, k0 = 64 * kb, n0 = 32 * nb;
#pragma unroll 8
    for (int i = 0; i < 32; ++i) { const int kk = 2 * i + (lane >> 5); scr[kk * 33 + (lane & 31)] = W[(size_t)(k0 + kk) * N + n0 + (lane & 31)]; }
    LDS_WAIT(); asm volatile("" ::: "memory");
    const int c = lane & 7;
#pragma unroll
    for (int j = 0; j < 4; ++j) { const int n = (lane >> 3) + 8 * j; const LAS float* s = scr + (8 * c) * 33 + n;
        u32x4 o; o.x = cvt_pk_bf16(s[0 * 33], s[1 * 33]); o.y = cvt_pk_bf16(s[2 * 33], s[3 * 33]); o.z = cvt_pk_bf16(s[4 * 33], s[5 * 33]); o.w = cvt_pk_bf16(s[6 * 33], s[7 * 33]);
        *(u32x4*)(WT + (size_t)(n0 + n) * K + k0 + 8 * c) = o; }
    LDS_WAIT(); asm volatile("" ::: "memory");
}
__device__ __forceinline__ void rms_row_to_bf16(const float* xrow, const float* gain, bf16_t* orow, int lane) {
    const f32x4* xr = (const f32x4*)xrow + lane; const f32x4* gr = (const f32x4*)gain + lane;
    f32x4 v[4]; float s = 0.f;
#pragma unroll
    for (int j = 0; j < 4; ++j) { v[j] = xr[64 * j]; s += (v[j][0] * v[j][0] + v[j][1] * v[j][1]) + (v[j][2] * v[j][2] + v[j][3] * v[j][3]); }
    const float rstd = rsqrtf(wave_sum(s) * (1.f / D) + EPS);
    u32x2* o8 = (u32x2*)orow + lane;
#pragma unroll
    for (int j = 0; j < 4; ++j) { const f32x4 w = v[j] * rstd * gr[64 * j]; u32x2 pk; pk.x = cvt_pk_bf16(w[0], w[1]); pk.y = cvt_pk_bf16(w[2], w[3]); o8[64 * j] = pk; }
}
__device__ __forceinline__ void phase_prologue(const Ctx& c, const Args& a) {
    unsigned char* ws = a.ws;
    LAS float* scr = (LAS float*)(c.lds + c.wave * 16384);
    struct WD { const float* W; int K, N; size_t off; };
    const WD wd[7] = { {a.in[I_WIN], D, WIN, WS_WIN}, {a.in[I_WOUT], D, D, WS_WOUT}, {a.in[I_WXQ], D, D, WS_WXQ}, {a.in[I_WXKV], D, 2 * D, WS_WXKV},
                       {a.in[I_WXO], D, D, WS_WXO}, {a.in[I_WUP], D, FF, WS_WUP}, {a.in[I_WDN], FF, D, WS_WDN} };
#pragma unroll
    for (int w = 0; w < 7; ++w) { const int nitems = (wd[w].K / 64) * (wd[w].N / 32);
        for (int it = c.gw; it < nitems; it += c.NGW) p0_transpose_item(wd[w].W, wd[w].K, wd[w].N, (bf16_t*)(ws + wd[w].off), scr, it, c.lane); }
    { u32x4* z = (u32x4*)(ws + WS_WIN + (size_t)WIN * D * 2); const int n16 = (NZP - WIN) * D * 2 / 16;
      for (int i = c.gw * 64 + c.lane; i < n16; i += c.NGW * 64) z[i] = (u32x4){0u, 0u, 0u, 0u}; }
    for (int m = c.gw; m < T; m += c.NGW) rms_row_to_bf16(a.in[I_X] + (size_t)m * D, a.in[I_MIXN], (bf16_t*)(ws + WS_XN) + (size_t)m * D, c.lane);
    for (int m = c.gw; m < MROWS; m += c.NGW) rms_row_to_bf16(a.in[I_MEM] + (size_t)m * D, a.in[I_MEMN], (bf16_t*)(ws + WS_MN) + (size_t)m * D, c.lane);
}

constexpr int GS = 144;
constexpr int L_QF = 0, L_KF = 9216, L_QB = 18432, L_KB = 27648, L_VT = 36864, L_AC = 55296, L_RED = 64512, L_WA = 66560, L_WB = 74752;
__device__ __forceinline__ bf16x8 gfrag(const LAS unsigned char* base, int r0, int ks, int fr, int fq) { return *(const LAS bf16x8*)(base + (r0 + fr) * GS + ks * 64 + fq * 16); }
__device__ __forceinline__ float logsig(float z) { return fminf(z, 0.f) - __logf(1.0f + __expf(-fabsf(z))); }

__device__ __forceinline__ void gla_load_w(const Ctx& c, const Args& a, int h) {
    const int idx = c.tid * 4, dir = idx >> 10, r = (idx >> 6) & 15, d = idx & 63;
    const float* src = (dir ? a.in[I_WAB] : a.in[I_WAF]) + r * 256 + h * 64 + d;
    *(LAS f32x4*)(c.lds + L_WA + idx * 4) = *(const f32x4*)src;
    if (c.tid < 32) { const int dr = c.tid >> 4, dd = (c.tid & 15) * 4; *(LAS f32x4*)(c.lds + L_WB + (dr * 64 + dd) * 4) = *(const f32x4*)((dr ? a.in[I_BAB] : a.in[I_BAF]) + h * 64 + dd); }
}
template <bool PASS_A>
__device__ __forceinline__ void gla_prep(const Ctx& c, const Args& a, int b, int h, int n, float* Gf, float* Gb) {
    const bf16_t* Z = (const bf16_t*)(a.ws + WS_Z); const float* LR = (const float*)(a.ws + WS_LR);
    const int t = c.lane, d0 = 8 * c.wave; const size_t row = (size_t)b * SEQ + n * 64 + t;
    const f32x4* lrp = (const f32x4*)(LR + row * 32);
    f32x4 l[8];
#pragma unroll
    for (int i = 0; i < 8; ++i) l[i] = lrp[i];
    const u32x4 qraw = *(const u32x4*)(Z + row * NZ + ZQ + h * 64 + d0), kraw = *(const u32x4*)(Z + row * NZ + ZK + h * 64 + d0);
    float qv[8], kv[8];
#pragma unroll
    for (int i = 0; i < 4; ++i) { qv[2 * i] = bf_lo(qraw[i]); qv[2 * i + 1] = bf_hi(qraw[i]); kv[2 * i] = bf_lo(kraw[i]); kv[2 * i + 1] = bf_hi(kraw[i]); }
    const LAS float* WA = (const LAS float*)(c.lds + L_WA); const LAS float* WB = (const LAS float*)(c.lds + L_WB);
    float zf[8], zb[8];
    { const f32x4 b0 = *(const LAS f32x4*)(WB + d0), b1 = *(const LAS f32x4*)(WB + d0 + 4), b2 = *(const LAS f32x4*)(WB + 64 + d0), b3 = *(const LAS f32x4*)(WB + 64 + d0 + 4);
#pragma unroll
      for (int i = 0; i < 4; ++i) { zf[i] = b0[i]; zf[4 + i] = b1[i]; zb[i] = b2[i]; zb[4 + i] = b3[i]; } }
#pragma unroll
    for (int r = 0; r < 16; ++r) {
        const f32x4 f0 = *(const LAS f32x4*)(WA + r * 64 + d0), f1 = *(const LAS f32x4*)(WA + r * 64 + d0 + 4);
        const f32x4 g0 = *(const LAS f32x4*)(WA + 1024 + r * 64 + d0), g1 = *(const LAS f32x4*)(WA + 1024 + r * 64 + d0 + 4);
        const float lf = l[r >> 2][r & 3], lb = l[4 + (r >> 2)][r & 3];
#pragma unroll
        for (int i = 0; i < 4; ++i) { zf[i] += lf * f0[i]; zf[4 + i] += lf * f1[i]; zb[i] += lb * g0[i]; zb[4 + i] += lb * g1[i]; }
        if (r & 1) {
#pragma unroll
            for (int i = 0; i < 8; ++i) asm volatile("" : "+v"(zf[i]), "+v"(zb[i])); }
    }
    float o0[8], o1[8], o2[8], o3[8];
#pragma unroll
    for (int i = 0; i < 8; ++i) {
        float bb = logsig(zf[i]) * (1.0f / 16.0f), cc = logsig(zb[i]) * (1.0f / 16.0f);
#pragma unroll
        for (int off = 1; off < 64; off <<= 1) { const float y = __shfl_up(bb, off); if (t >= off) bb += y; const float w = __shfl_down(cc, off); if (t + off < 64) cc += w; }
        if (PASS_A) {
            const float b63 = __shfl(bb, 63), c0 = __shfl(cc, 0);
            o0[i] = kv[i] * __expf(b63 - bb); o1[i] = kv[i] * __expf(c0 - cc);
            if (t == 63) Gf[d0 + i] = bb;
            if (t == 0) Gb[d0 + i] = cc;
        } else {
            const float eb = __expf(bb), ec = __expf(cc);
            o0[i] = qv[i] * 0.125f * eb; o1[i] = kv[i] * __expf(-bb); o2[i] = qv[i] * 0.125f * ec; o3[i] = kv[i] * __expf(-cc);
        }
    }
    if (PASS_A) {
#pragma unroll
        for (int i = 0; i < 8; i += 2) { const unsigned pf = cvt_pk_bf16(o0[i], o0[i + 1]), pb = cvt_pk_bf16(o1[i], o1[i + 1]);
            *(LAS bf16_t*)(c.lds + L_QF + (d0 + i) * GS + t * 2) = (bf16_t)(pf & 0xffffu); *(LAS bf16_t*)(c.lds + L_QF + (d0 + i + 1) * GS + t * 2) = (bf16_t)(pf >> 16);
            *(LAS bf16_t*)(c.lds + L_KF + (d0 + i) * GS + t * 2) = (bf16_t)(pb & 0xffffu); *(LAS bf16_t*)(c.lds + L_KF + (d0 + i + 1) * GS + t * 2) = (bf16_t)(pb >> 16); }
    } else {
        u32x4 w0, w1, w2, w3;
#pragma unroll
        for (int i = 0; i < 4; ++i) { w0[i] = cvt_pk_bf16(o0[2 * i], o0[2 * i + 1]); w1[i] = cvt_pk_bf16(o1[2 * i], o1[2 * i + 1]); w2[i] = cvt_pk_bf16(o2[2 * i], o2[2 * i + 1]); w3[i] = cvt_pk_bf16(o3[2 * i], o3[2 * i + 1]); }
        *(LAS u32x4*)(c.lds + L_QF + t * GS + d0 * 2) = w0; *(LAS u32x4*)(c.lds + L_KF + t * GS + d0 * 2) = w1;
        *(LAS u32x4*)(c.lds + L_QB + t * GS + d0 * 2) = w2; *(LAS u32x4*)(c.lds + L_KB + t * GS + d0 * 2) = w3;
    }
    const int e0 = 16 * c.wave; const u32x4* vp = (const u32x4*)(Z + row * NZ + ZV + h * 128 + e0);
    const u32x4 va = vp[0], vb = vp[1];
#pragma unroll
    for (int i = 0; i < 4; ++i) {
        *(LAS bf16_t*)(c.lds + L_VT + (e0 + 2 * i) * GS + t * 2) = (bf16_t)(va[i] & 0xffffu); *(LAS bf16_t*)(c.lds + L_VT + (e0 + 2 * i + 1) * GS + t * 2) = (bf16_t)(va[i] >> 16);
        *(LAS bf16_t*)(c.lds + L_VT + (e0 + 8 + 2 * i) * GS + t * 2) = (bf16_t)(vb[i] & 0xffffu); *(LAS bf16_t*)(c.lds + L_VT + (e0 + 8 + 2 * i + 1) * GS + t * 2) = (bf16_t)(vb[i] >> 16); }
}

__device__ __forceinline__ void phase_gla_a(const Ctx& c, const Args& a) {
    float* UU = (float*)(a.ws + WS_UU); float* GG = (float*)(a.ws + WS_GG);
    const int fr = c.lane & 15, fq = c.lane >> 4, w = c.wave;
    int h_loaded = -1;
    for (int uu = blockIdx.x; uu < NUNIT; uu += c.G) {
        const int h = uu & 3, n = (uu >> 2) & (NCH - 1), b = uu >> 9, unit = (b * GH + h) * NCH + n;
        __syncthreads();
        if (h != h_loaded) { gla_load_w(c, a, h); h_loaded = h; __syncthreads(); }
        gla_prep<true>(c, a, b, h, n, GG + (size_t)unit * 64, GG + (size_t)(NUNIT + unit) * 64);
        __syncthreads();
        bf16x8 av[2];
#pragma unroll
        for (int ks = 0; ks < 2; ++ks) av[ks] = gfrag(c.lds + L_VT, 16 * w, ks, fr, fq);
#pragma unroll
        for (int dir = 0; dir < 2; ++dir)
#pragma unroll
            for (int dt = 0; dt < 4; ++dt) { f32x4 acc = (f32x4){0.f, 0.f, 0.f, 0.f};
#pragma unroll
                for (int ks = 0; ks < 2; ++ks) acc = __builtin_amdgcn_mfma_f32_16x16x32_bf16(av[ks], gfrag(c.lds + (dir ? L_KF : L_QF), 16 * dt, ks, fr, fq), acc, 0, 0, 0);
                float* up = UU + ((size_t)(dir * NUNIT + unit) * 128 + 16 * w + 4 * fq) * 64 + 16 * dt + fr;
#pragma unroll
                for (int i = 0; i < 4; ++i) up[i * 64] = acc[i]; }
    }
}
__device__ __forceinline__ void phase_conv(const Ctx& c, const Args& a) {
    const bf16_t* Z = (const bf16_t*)(a.ws + WS_Z); bf16_t* Y = (bf16_t*)(a.ws + WS_Y);
    const float* cw = a.in[I_CONVW]; const float* cn = a.in[I_CONVN];
    const int c0 = 8 * c.lane;
    float w0[8], w1[8], w2[8], gn[8];
#pragma unroll
    for (int i = 0; i < 8; ++i) { w0[i] = cw[c0 + i]; w1[i] = cw[512 + c0 + i]; w2[i] = cw[1024 + c0 + i]; gn[i] = cn[c0 + i]; }
    for (int tok = c.gw; tok < T; tok += c.NGW) {
        const int s = tok % SEQ; const bf16_t* zr = Z + (size_t)tok * NZ + c0;
        const u32x4 cb = *(const u32x4*)(zr + ZCB), cc0 = *(const u32x4*)(zr + ZCC), cu0 = *(const u32x4*)(zr + ZCU);
        u32x4 ccm = (u32x4){0u, 0u, 0u, 0u}, cum = ccm, ccp = ccm, cup = ccm;
        if (s > 0) { ccm = *(const u32x4*)(zr - NZ + ZCC); cum = *(const u32x4*)(zr - NZ + ZCU); }
        if (s < SEQ - 1) { ccp = *(const u32x4*)(zr + NZ + ZCC); cup = *(const u32x4*)(zr + NZ + ZCU); }
        float y[8]; float ss = 0.f;
#pragma unroll
        for (int i = 0; i < 4; ++i) {
            const float hm0 = bf_lo(ccm[i]) * bf_lo(cum[i]), hm1 = bf_hi(ccm[i]) * bf_hi(cum[i]);
            const float h00 = bf_lo(cc0[i]) * bf_lo(cu0[i]), h01 = bf_hi(cc0[i]) * bf_hi(cu0[i]);
            const float hp0 = bf_lo(ccp[i]) * bf_lo(cup[i]), hp1 = bf_hi(ccp[i]) * bf_hi(cup[i]);
            y[2 * i] = bf_lo(cb[i]) * (w0[2 * i] * hm0 + w1[2 * i] * h00 + w2[2 * i] * hp0);
            y[2 * i + 1] = bf_hi(cb[i]) * (w0[2 * i + 1] * hm1 + w1[2 * i + 1] * h01 + w2[2 * i + 1] * hp1);
            ss += y[2 * i] * y[2 * i] + y[2 * i + 1] * y[2 * i + 1]; }
        ss += __shfl_xor(ss, 1); ss += __shfl_xor(ss, 2); ss += __shfl_xor(ss, 4);
        const float rstd = rsqrtf(ss * (1.0f / 64.0f) + EPS);
        u32x4 o;
#pragma unroll
        for (int i = 0; i < 4; ++i) o[i] = cvt_pk_bf16(y[2 * i] * rstd * gn[2 * i], y[2 * i + 1] * rstd * gn[2 * i + 1]);
        *(u32x4*)(Y + (size_t)tok * D + c0) = o;
    }
}
__device__ __forceinline__ void phase_scan(const Ctx& c, const Args& a) {
    const float* UU = (const float*)(a.ws + WS_UU); const float* GG = (const float*)(a.ws + WS_GG); bf16_t* SS = (bf16_t*)(a.ws + WS_SS);
    const int nthreads = c.G * 512;
    for (int idx = blockIdx.x * 512 + c.tid; idx < 2 * 16 * 8192; idx += nthreads) {
        const int dir = idx / (16 * 8192), rem = idx % (16 * 8192), bh = rem / 8192, ed = rem % 8192, d = ed & 63;
        const size_t ubase = (size_t)dir * NUNIT + (size_t)bh * NCH;
        float S = 0.f;
        for (int n0 = 0; n0 < NCH; n0 += 8) {
            float u[8], g[8];
#pragma unroll
            for (int j = 0; j < 8; ++j) { const int n = dir ? (NCH - 1 - (n0 + j)) : (n0 + j); u[j] = UU[(ubase + n) * 8192 + ed]; g[j] = GG[(ubase + n) * 64 + d]; }
#pragma unroll
            for (int j = 0; j < 8; ++j) { const int n = dir ? (NCH - 1 - (n0 + j)) : (n0 + j);
                SS[(ubase + n) * 8192 + ed] = (bf16_t)(cvt_pk_bf16(S, 0.f) & 0xffffu);
                S = __expf(g[j]) * S + u[j]; }
        }
    }
}
__device__ __forceinline__ void phase_gla_c(const Ctx& c, const Args& a) {
    const bf16_t* Z = (const bf16_t*)(a.ws + WS_Z); const bf16_t* SS = (const bf16_t*)(a.ws + WS_SS); bf16_t* Y = (bf16_t*)(a.ws + WS_Y);
    const int fr = c.lane & 15, fq = c.lane >> 4, w = c.wave;
    const f32x4 gnv = *(const f32x4*)(a.in[I_GLAN] + 16 * w + 4 * fq);
    LAS float* red = (LAS float*)(c.lds + L_RED);
    int h_loaded = -1;
    for (int uu = blockIdx.x; uu < NUNIT; uu += c.G) {
        const int h = uu & 3, n = (uu >> 2) & (NCH - 1), b = uu >> 9, unit = (b * GH + h) * NCH + n;
        __syncthreads();
        if (h != h_loaded) { gla_load_w(c, a, h); h_loaded = h; __syncthreads(); }
        gla_prep<false>(c, a, b, h, n, nullptr, nullptr);
        bf16x8 asf[2], asb[2];
#pragma unroll
        for (int ks = 0; ks < 2; ++ks) { asf[ks] = *(const bf16x8*)(SS + ((size_t)unit * 128 + 16 * w + fr) * 64 + 32 * ks + 8 * fq);
                                          asb[ks] = *(const bf16x8*)(SS + ((size_t)(NUNIT + unit) * 128 + 16 * w + fr) * 64 + 32 * ks + 8 * fq); }
        __syncthreads();
        { const int tt = w & 3;
#pragma unroll
          for (int s2 = 0; s2 < 2; ++s2) { const int ss = 2 * (w >> 2) + s2; f32x4 af = (f32x4){0.f, 0.f, 0.f, 0.f}, ab = af;
              if (ss <= tt) {
#pragma unroll
                  for (int ks = 0; ks < 2; ++ks) af = __builtin_amdgcn_mfma_f32_16x16x32_bf16(gfrag(c.lds + L_KF, 16 * ss, ks, fr, fq), gfrag(c.lds + L_QF, 16 * tt, ks, fr, fq), af, 0, 0, 0); }
              if (ss >= tt) {
#pragma unroll
                  for (int ks = 0; ks < 2; ++ks) ab = __builtin_amdgcn_mfma_f32_16x16x32_bf16(gfrag(c.lds + L_KB, 16 * ss, ks, fr, fq), gfrag(c.lds + L_QB, 16 * tt, ks, fr, fq), ab, 0, 0, 0); }
              const int tpos = 16 * tt + fr, s0 = 16 * ss + 4 * fq; float v[4];
#pragma unroll
              for (int i = 0; i < 4; ++i) v[i] = (s0 + i <= tpos) ? af[i] : ab[i];
              u32x2 pk; pk.x = cvt_pk_bf16(v[0], v[1]); pk.y = cvt_pk_bf16(v[2], v[3]);
              *(LAS u32x2*)(c.lds + L_AC + tpos * GS + s0 * 2) = pk; } }
        __syncthreads();
        bf16x8 av[2];
#pragma unroll
        for (int ks = 0; ks < 2; ++ks) av[ks] = gfrag(c.lds + L_VT, 16 * w, ks, fr, fq);
        f32x4 o[4];
#pragma unroll
        for (int tt = 0; tt < 4; ++tt) { f32x4 acc = (f32x4){0.f, 0.f, 0.f, 0.f};
#pragma unroll
            for (int ks = 0; ks < 2; ++ks) { acc = __builtin_amdgcn_mfma_f32_16x16x32_bf16(av[ks], gfrag(c.lds + L_AC, 16 * tt, ks, fr, fq), acc, 0, 0, 0);
                acc = __builtin_amdgcn_mfma_f32_16x16x32_bf16(asf[ks], gfrag(c.lds + L_QF, 16 * tt, ks, fr, fq), acc, 0, 0, 0);
                acc = __builtin_amdgcn_mfma_f32_16x16x32_bf16(asb[ks], gfrag(c.lds + L_QB, 16 * tt, ks, fr, fq), acc, 0, 0, 0); }
            o[tt] = acc;
            float p = (acc[0] * acc[0] + acc[1] * acc[1]) + (acc[2] * acc[2] + acc[3] * acc[3]);
            p += __shfl_xor(p, 16); p += __shfl_xor(p, 32);
            if (fq == 0) red[w * 64 + 16 * tt + fr] = p; }
        __syncthreads();
#pragma unroll
        for (int tt = 0; tt < 4; ++tt) { const int tpos = 16 * tt + fr; float s = 0.f;
#pragma unroll
            for (int ww = 0; ww < 8; ++ww) s += red[ww * 64 + tpos];
            const float rstd = rsqrtf(s * (1.0f / 128.0f) + EPS);
            const size_t row = (size_t)b * SEQ + n * 64 + tpos;
            const u32x2 gr = *(const u32x2*)(Z + row * NZ + ZG + h * 128 + 16 * w + 4 * fq);
            const float g4[4] = {bf_lo(gr.x), bf_hi(gr.x), bf_lo(gr.y), bf_hi(gr.y)}; float y[4];
#pragma unroll
            for (int i = 0; i < 4; ++i) y[i] = o[tt][i] * rstd * gnv[i] * (g4[i] / (1.0f + __expf(-g4[i])));
            u32x2 pk; pk.x = cvt_pk_bf16(y[0], y[1]); pk.y = cvt_pk_bf16(y[2], y[3]);
            *(u32x2*)(Y + row * D + 512 + h * 128 + 16 * w + 4 * fq) = pk; }
    }
}
__device__ __forceinline__ void phase_final(const Ctx& c, const Args& a) {
    const float* gain = a.in[I_FINN];
    for (int m = c.gw; m < T; m += c.NGW) {
        f32x4* xr = (f32x4*)(a.out + (size_t)m * D) + c.lane; const f32x4* gr = (const f32x4*)gain + c.lane;
        f32x4 v[4]; float s = 0.f;
#pragma unroll
        for (int j = 0; j < 4; ++j) { v[j] = xr[64 * j]; s += (v[j][0] * v[j][0] + v[j][1] * v[j][1]) + (v[j][2] * v[j][2] + v[j][3] * v[j][3]); }
        const float rstd = rsqrtf(wave_sum(s) * (1.f / D) + EPS);
#pragma unroll
        for (int j = 0; j < 4; ++j) xr[64 * j] = v[j] * rstd * gr[64 * j];
    }
}

__device__ __forceinline__ int lane_id_opaque() { int l; asm volatile("v_mbcnt_lo_u32_b32 %0, -1, 0\n\tv_mbcnt_hi_u32_b32 %0, -1, %0" : "=v"(l)); return l; }
typedef __attribute__((address_space(4))) const Args* KArgP;
__device__ __forceinline__ Args load_args() {
    Args a{};
#if defined(__HIP_DEVICE_COMPILE__)
    KArgP p = (KArgP)__builtin_amdgcn_kernarg_segment_ptr(); asm volatile("" : "+s"(p));
#pragma unroll
    for (int i = 0; i < 21; ++i) a.in[i] = p->in[i];
    a.out = p->out; a.ws = p->ws; a.ph_lo = p->ph_lo; a.ph_hi = p->ph_hi;
#endif
    return a;
}
#define XB_TMO      128
#define XB_XCNT(j)  (256  + 64 * (j))
#define XB_XSUB(j)  (1280 + 64 * (j))
#define XB_XGEN(j)  (2304 + 64 * (j))
#define XB_TOP      3328
#define XB_TOPGEN   3392
#define XCD_BAR_WORDS 3456
#define XB_SPIN_CAP (1u << 18)
__device__ __forceinline__ unsigned xb_ld(unsigned* p)              { return __hip_atomic_load(p, __ATOMIC_RELAXED, __HIP_MEMORY_SCOPE_AGENT); }
__device__ __forceinline__ unsigned xb_add(unsigned* p, unsigned v) { return __hip_atomic_fetch_add(p, v, __ATOMIC_RELAXED, __HIP_MEMORY_SCOPE_AGENT); }
__device__ __forceinline__ unsigned xb_xcc_id() { return (unsigned)__builtin_amdgcn_s_getreg((3 << 11) | 20) & 0xFu; }
#define XB_SPIN(cond, bar) do { unsigned _sp = 0; while (cond) { __builtin_amdgcn_s_sleep(1); \
    if ((++_sp & 255u) == 0u) { if (xb_ld(&(bar)[XB_TMO])) break; if (_sp > XB_SPIN_CAP) { atomicAdd(&(bar)[XB_TMO], 1u); break; } } } } while (0)
__device__ __forceinline__ void xcd_barrier_complete(unsigned* bar, unsigned x, unsigned& nloc, unsigned& nx) {
    const unsigned G = gridDim.x;
    unsigned sum, cnt, mine, sp = 0u;
    for (;;) {
        sum = 0u; cnt = 0u; mine = 0u;
#pragma unroll
        for (unsigned j = 0; j < 16; ++j) { const unsigned c = xb_ld(&bar[XB_XCNT(j)]); sum += c; cnt += (c > 0u) ? 1u : 0u; mine = (j == x) ? c : mine; }
        if (sum == G) break;
        __builtin_amdgcn_s_sleep(1);
        if ((++sp & 255u) == 0u) { if (xb_ld(&bar[XB_TMO])) break; if (sp > XB_SPIN_CAP) { atomicAdd(&bar[XB_TMO], 1u); break; } }
    }
    nloc = mine > 0u ? mine : 1u; nx = cnt > 0u ? cnt : 1u;
}
__device__ __forceinline__ void xcd_barrier(unsigned* bar, volatile LAS unsigned* st, bool first) {
    asm volatile("s_waitcnt vmcnt(0)" ::: "memory");
    __syncthreads();
    if (first) {
        const unsigned x = xb_xcc_id();
        __builtin_amdgcn_s_waitcnt(0);
        unsigned nloc = st[0], nx = st[1];
        if (nloc == 0u) { xcd_barrier_complete(bar, x, nloc, nx); st[0] = nloc; st[1] = nx; }
        const unsigned old = xb_add(&bar[XB_XSUB(x)], 1u);
        const unsigned gen = old / nloc;
        if (old + 1u == (gen + 1u) * nloc) {
            __builtin_amdgcn_fence(__ATOMIC_RELEASE, "agent");
            asm volatile("s_waitcnt vmcnt(0)" ::: "memory");
            const unsigned og = xb_add(&bar[XB_TOP], 1u);
            const unsigned tg = og / nx;
            if (og + 1u == (tg + 1u) * nx) xb_add(&bar[XB_TOPGEN], 1u);
            else XB_SPIN(xb_ld(&bar[XB_TOPGEN]) == tg, bar);
            __builtin_amdgcn_fence(__ATOMIC_ACQUIRE, "agent");
            xb_add(&bar[XB_XGEN(x)], 1u);
            asm volatile("s_waitcnt vmcnt(0)" ::: "memory");
        } else {
            XB_SPIN(xb_ld(&bar[XB_XGEN(x)]) == gen, bar);
            __builtin_amdgcn_fence(__ATOMIC_ACQUIRE, "agent");
            asm volatile("s_waitcnt vmcnt(0)" ::: "memory");
        }
    }
    __syncthreads();
}
constexpr int MISC_OFF = 139264;
__global__ void __launch_bounds__(512, 2) mk_fwd(Args args_unused) {
    extern __shared__ __attribute__((aligned(16))) unsigned char lds_raw[];
    const int wave0 = __builtin_amdgcn_readfirstlane(threadIdx.x >> 6);
#define MAKE_CTX() Ctx c; c.lds = (LAS unsigned char*)lds_raw; c.wave = wave0; c.lane = lane_id_opaque(); c.tid = c.wave * 64 + c.lane; c.G = gridDim.x; c.gw = blockIdx.x * 8 + c.wave; c.NGW = c.G * 8
    int lo, hi; { const Args a0 = load_args(); lo = a0.ph_lo; hi = a0.ph_hi; }
#if MK_MODE == 1
#define GRID_BAR(k) cg::this_grid().sync()
#elif MK_MODE == 2
    unsigned* const xbar = (unsigned*)(load_args().ws + WS_CTL);
    volatile LAS unsigned* const xst = (volatile LAS unsigned*)((LAS unsigned char*)lds_raw + MISC_OFF);
    { const int l0 = lane_id_opaque(); if (wave0 == 0 && l0 < 4) xst[l0] = 0u; __syncthreads();
      if (wave0 == 0 && l0 == 0) (void)xb_add(&xbar[XB_XCNT(xb_xcc_id())], 1u); }
#if MK_CG_FIRST
#define GRID_BAR(k) do { if ((k) == 0) cg::this_grid().sync(); else xcd_barrier(xbar, xst, wave0 == 0 && lane_id_opaque() == 0); } while (0)
#else
#define GRID_BAR(k) xcd_barrier(xbar, xst, wave0 == 0 && lane_id_opaque() == 0)
#endif
#else
#define GRID_BAR(k) do { } while (0)
#endif
#ifndef PHASE_MASK
#define PHASE_MASK 0x1fff
#endif
#define IN(k) (((PHASE_MASK >> (k)) & 1) && lo <= (k) && (k) < hi)
#define SEAM(k) do { if (IN(k) && IN((k) + 1)) { GRID_BAR(k); } } while (0)
    using namespace pg8;

    if (IN(0)) { MAKE_CTX(); const Args args = load_args(); phase_prologue(c, args); SEAM(0); }
    if (IN(1)) { MAKE_CTX(); const Args args = load_args(); unsigned char* ws = args.ws; bf16_t* XN = (bf16_t*)(ws + WS_XN);
        { ProbPlain g{XN, (const bf16_t*)(ws + WS_WIN), D, D, D}; StaticOrder S; S.init(T, NZP, c.G, (int)blockIdx.x);
          EpiZ E{(bf16_t*)(ws + WS_Z), (float*)(ws + WS_LR)};
          gemm_phase<EpiZ, ProbPlain, StaticOrder, true>(c.lds, c.tid, c.wave, g, S, E); }
        __syncthreads();
        { ProbPlain g{(const bf16_t*)(ws + WS_MN), (const bf16_t*)(ws + WS_WXKV), D, D, D}; StaticOrder S; S.init(MROWS, 2 * D, c.G, (int)blockIdx.x);
          EpiKV E{(bf16_t*)(ws + WS_KMEM), (bf16_t*)(ws + WS_VT)};
          gemm_phase<EpiKV, ProbPlain, StaticOrder, true>(c.lds, c.tid, c.wave, g, S, E); }
        SEAM(1);
    }
    if (IN(2)) { MAKE_CTX(); const Args args = load_args();
#ifndef NO_GLA_A
        phase_gla_a(c, args);
#endif
#ifndef NO_CONV
        phase_conv(c, args);
#endif
        SEAM(2); }
    if (IN(3)) { MAKE_CTX(); const Args args = load_args(); phase_scan(c, args); SEAM(3); }
    if (IN(4)) { MAKE_CTX(); const Args args = load_args(); phase_gla_c(c, args); SEAM(4); }
    if (IN(5)) { MAKE_CTX(); const Args args = load_args(); unsigned char* ws = args.ws; bf16_t* XN = (bf16_t*)(ws + WS_XN); float* SSQ = (float*)(ws + WS_SSQ); (void)XN; (void)SSQ;
        ProbPlain g{(const bf16_t*)(ws + WS_Y), (const bf16_t*)(ws + WS_WOUT), D, D, D}; StaticOrder S; S.init(T, D, c.G, (int)blockIdx.x);
        EpiRes<true> E{args.in[I_X], args.out, args.in[I_XAN], XN, SSQ};
        gemm_phase<EpiRes<true>, ProbPlain, StaticOrder, true>(c.lds, c.tid, c.wave, g, S, E);
        SEAM(5);
    }
    if (IN(6)) { MAKE_CTX(); const Args args = load_args(); unsigned char* ws = args.ws; bf16_t* XN = (bf16_t*)(ws + WS_XN); float* SSQ = (float*)(ws + WS_SSQ); (void)XN; (void)SSQ;
        ProbPlain g{XN, (const bf16_t*)(ws + WS_WXQ), D, D, D}; StaticOrder S; S.init(T, D, c.G, (int)blockIdx.x);
        EpiScale<0> E{(bf16_t*)(ws + WS_HQ), D, SSQ, 1.0f / 16.0f};
        gemm_phase<EpiScale<0>, ProbPlain, StaticOrder, true>(c.lds, c.tid, c.wave, g, S, E);
        SEAM(6);
    }
    if (IN(7)) { MAKE_CTX(); const Args args = load_args(); unsigned char* ws = args.ws; bf16_t* XN = (bf16_t*)(ws + WS_XN); float* SSQ = (float*)(ws + WS_SSQ); (void)XN; (void)SSQ;
        ProbQK g{(const bf16_t*)(ws + WS_HQ), (const bf16_t*)(ws + WS_KMEM), D, D, 256}; StaticOrder S; S.init(T, D, c.G, (int)blockIdx.x);
        EpiSoftmax E{(bf16_t*)(ws + WS_P), D, (LAS float*)(c.lds + EPI_LDS_OFF)};
        gemm_phase<EpiSoftmax, ProbQK, StaticOrder, true>(c.lds, c.tid, c.wave, g, S, E);
        SEAM(7);
    }
    if (IN(8)) { MAKE_CTX(); const Args args = load_args(); unsigned char* ws = args.ws; bf16_t* XN = (bf16_t*)(ws + WS_XN); float* SSQ = (float*)(ws + WS_SSQ); (void)XN; (void)SSQ;
        ProbPV g{(const bf16_t*)(ws + WS_P), (const bf16_t*)(ws + WS_VT), D, 256, 256}; StaticOrder S; S.init(T, D, c.G, (int)blockIdx.x);
        EpiBf16 E{(bf16_t*)(ws + WS_O), D};
        gemm_phase<EpiBf16, ProbPV, StaticOrder, true>(c.lds, c.tid, c.wave, g, S, E);
        SEAM(8);
    }
    if (IN(9)) { MAKE_CTX(); const Args args = load_args(); unsigned char* ws = args.ws; bf16_t* XN = (bf16_t*)(ws + WS_XN); float* SSQ = (float*)(ws + WS_SSQ); (void)XN; (void)SSQ;
        ProbPlain g{(const bf16_t*)(ws + WS_O), (const bf16_t*)(ws + WS_WXO), D, D, D}; StaticOrder S; S.init(T, D, c.G, (int)blockIdx.x);
        EpiRes<true> E{args.out, (float*)(ws + WS_RB), args.in[I_MLPN], XN, SSQ};
        gemm_phase<EpiRes<true>, ProbPlain, StaticOrder, true>(c.lds, c.tid, c.wave, g, S, E);
        SEAM(9);
    }
    if (IN(10)) { MAKE_CTX(); const Args args = load_args(); unsigned char* ws = args.ws; bf16_t* XN = (bf16_t*)(ws + WS_XN); float* SSQ = (float*)(ws + WS_SSQ); (void)XN; (void)SSQ;
        ProbPlain g{XN, (const bf16_t*)(ws + WS_WUP), D, D, D}; StaticOrder S; S.init(T, FF, c.G, (int)blockIdx.x);
        EpiScale<1> E{(bf16_t*)(ws + WS_U), FF, SSQ, 1.0f};
        gemm_phase<EpiScale<1>, ProbPlain, StaticOrder, true>(c.lds, c.tid, c.wave, g, S, E);
        SEAM(10);
    }
    if (IN(11)) { MAKE_CTX(); const Args args = load_args(); unsigned char* ws = args.ws; bf16_t* XN = (bf16_t*)(ws + WS_XN); float* SSQ = (float*)(ws + WS_SSQ); (void)XN; (void)SSQ;
        ProbPlain g{(const bf16_t*)(ws + WS_U), (const bf16_t*)(ws + WS_WDN), FF, FF, FF}; StaticOrder S; S.init(T, D, c.G, (int)blockIdx.x);
        EpiRes<false> E{(const float*)(ws + WS_RB), args.out, nullptr, nullptr, nullptr};
        gemm_phase<EpiRes<false>, ProbPlain, StaticOrder, true>(c.lds, c.tid, c.wave, g, S, E);
        SEAM(11);
    }
    if (IN(12)) { MAKE_CTX(); const Args args = load_args(); phase_final(c, args); }
#undef IN
#undef SEAM
#undef GRID_BAR
}

extern "C" void kernel_launch(void* const* d_in, const int* in_sizes, int n_in, void* d_out, int out_size, void* d_ws, size_t ws_size, hipStream_t stream) {
    static int grid = 0;
    if (grid == 0) {
        if (n_in != 21 || in_sizes[0] != T * D || out_size != T * D || ws_size < WS_END) {
            fprintf(stderr, "kernel_launch: unexpected shapes: n_in %d in0 %d out %d ws %zu (need %zu); nothing launched\n", n_in, n_in > 0 ? in_sizes[0] : -1, out_size, ws_size, (size_t)WS_END); grid = -1; return; }
        int dev = 0, cus = 0, per_cu = 0;
        if (hipGetDevice(&dev) != hipSuccess || hipDeviceGetAttribute(&cus, hipDeviceAttributeMultiprocessorCount, dev) != hipSuccess) { fprintf(stderr, "kernel_launch: device query failed\n"); grid = -1; return; }
        if (hipFuncSetAttribute((const void*)mk_fwd, hipFuncAttributeMaxDynamicSharedMemorySize, LDS_BYTES) != hipSuccess) { fprintf(stderr, "kernel_launch: hipFuncSetAttribute failed\n"); grid = -1; return; }
        if (hipOccupancyMaxActiveBlocksPerMultiprocessor(&per_cu, (const void*)mk_fwd, 512, LDS_BYTES) != hipSuccess || per_cu < 1) { fprintf(stderr, "kernel_launch: occupancy query says %d blocks per CU\n", per_cu); (void)hipGetLastError(); grid = -1; return; }
        grid = cus * (per_cu < 1 ? 1 : 1);
        fprintf(stderr, "kernel_launch: %d CUs, occupancy query %d per CU, grid %d\n", cus, per_cu, grid);
    }
    if (grid < 0) return;
    Args a{};
    for (int i = 0; i < 21; ++i) a.in[i] = (const float*)d_in[i];
    a.out = (float*)d_out; a.ws = (unsigned char*)d_ws;
#if MK_MODE == 0
    for (int p = 0; p < N_PHASES; ++p) { a.ph_lo = p; a.ph_hi = p + 1; hipLaunchKernelGGL(mk_fwd, dim3(grid), dim3(512), LDS_BYTES, stream, a); }
#else
    a.ph_lo = 0; a.ph_hi = N_PHASES;
#if MK_MODE == 2
    if (hipMemsetAsync((char*)d_ws + WS_CTL, 0, 65536, stream) != hipSuccess) { fprintf(stderr, "kernel_launch: memset of the barrier words failed\n"); return; }
#endif
#if MK_MODE == 2 && !MK_CG_FIRST
    hipLaunchKernelGGL(mk_fwd, dim3(grid), dim3(512), LDS_BYTES, stream, a);
#else
    void* kargs[] = {&a};
    hipError_t e = hipLaunchCooperativeKernel((const void*)mk_fwd, dim3(grid), dim3(512), kargs, LDS_BYTES, stream);
    if (e != hipSuccess) fprintf(stderr, "kernel_launch: cooperative launch failed: %s (grid %d)\n", hipGetErrorString(e), grid);
#endif
#endif
}
```

```cpp
#include <hip/hip_runtime.h>
#include <hip/hip_cooperative_groups.h>
#include <cstdio>
#include <cstdint>
namespace cg = cooperative_groups;

#ifndef MK_MODE
#define MK_MODE 2
#endif
#ifndef MK_CG_FIRST
#define MK_CG_FIRST 0
#endif

#define LAS __attribute__((address_space(3)))
typedef unsigned short bf16_t;
typedef short bf16x8 __attribute__((ext_vector_type(8)));
typedef float f32x4 __attribute__((ext_vector_type(4)));
typedef float f32x2 __attribute__((ext_vector_type(2)));
typedef unsigned u32x4 __attribute__((ext_vector_type(4)));
typedef unsigned u32x2 __attribute__((ext_vector_type(2)));

constexpr int BATCH = 4, SEQ = 8192, T = BATCH * SEQ, D = 1024, NMEM = 256, MROWS = BATCH * NMEM;
constexpr int WIN = 3104, NZ = 3072, NZP = 3328, FF = 4096;
constexpr int ZCB = 0, ZCC = 512, ZCU = 1024, ZQ = 1536, ZK = 1792, ZV = 2048, ZG = 2560;
constexpr int GH = 4, NCH = SEQ / 64, NUNIT = BATCH * GH * NCH;
constexpr float EPS = 1e-6f;

constexpr size_t MiB = 1u << 20;
constexpr size_t WS_CTL = 0;
constexpr size_t WS_WIN = 1 * MiB;
constexpr size_t WS_WOUT = 8 * MiB;
constexpr size_t WS_WXQ = 10 * MiB;
constexpr size_t WS_WXKV = 12 * MiB;
constexpr size_t WS_WXO = 16 * MiB;
constexpr size_t WS_WUP = 18 * MiB;
constexpr size_t WS_WDN = 26 * MiB;
constexpr size_t WS_MN = 34 * MiB;
constexpr size_t WS_KMEM = 36 * MiB;
constexpr size_t WS_VT = 38 * MiB;
constexpr size_t WS_SSQ = 40 * MiB;
constexpr size_t WS_LR = 42 * MiB;
constexpr size_t WS_GG = 46 * MiB;
constexpr size_t WS_XN = 48 * MiB;
constexpr size_t WS_SS = 48 * MiB;
constexpr size_t WS_Y = 112 * MiB;
constexpr size_t WS_HQ = 112 * MiB;
constexpr size_t WS_Z = 176 * MiB;
constexpr size_t WS_P = 176 * MiB;
constexpr size_t WS_O = 240 * MiB;
constexpr size_t WS_UU = 368 * MiB;
constexpr size_t WS_RB = 368 * MiB;
constexpr size_t WS_U = 112 * MiB;
constexpr size_t WS_END = 496 * MiB;

constexpr int LDS_BYTES = 147456;
constexpr int RING_BYTES = 131072;
constexpr int EPI_LDS_OFF = RING_BYTES;

__device__ __forceinline__ unsigned cvt_pk_bf16(float lo, float hi) { unsigned r; asm volatile("v_cvt_pk_bf16_f32 %0, %1, %2" : "=v"(r) : "v"(lo), "v"(hi)); return r; }
__device__ __forceinline__ float bf_lo(unsigned x) { return __uint_as_float(x << 16); }
__device__ __forceinline__ float bf_hi(unsigned x) { return __uint_as_float(x & 0xffff0000u); }
__device__ __forceinline__ float wave_sum(float v) {
#pragma unroll
    for (int o = 1; o < 64; o <<= 1) v += __shfl_xor(v, o);
    return v;
}
#define LDS_WAIT() asm volatile("s_waitcnt lgkmcnt(0)" ::: "memory")
#define VM_WAIT() asm volatile("s_waitcnt vmcnt(0)" ::: "memory")

namespace pg8 {
constexpr int BM = 256, BK = 64, HALF = 128, HTB = HALF * BK * 2, STAGE_BYTES = 8 * HTB, NXCD = 8, WGM = 8;
__host__ __device__ __forceinline__ int lds_byte(int r, int c) { const int st = (r >> 4) * 2 + (c >> 5), rr = r & 15, cc = c & 31, ob = rr * 64 + cc * 2; return st * 1024 + (ob ^ (((ob >> 9) & 1) << 5)); }
__host__ __device__ __forceinline__ void stage_rc(int b, int& R, int& C) { const int st = b / 1024, sb = b % 1024, swz = sb ^ (((sb >> 9) & 1) << 5); R = (st >> 1) * 16 + swz / 64; C = (st & 1) * 32 + (swz % 64) / 2; }
__host__ __device__ __forceinline__ int perm32(int rho) { const int n = rho >> 4, i = rho & 15; return 8 * (i >> 2) + 4 * n + (i & 3); }

struct Unit { int pm, pn; };

struct StaticOrder {
    int nM, nN, nwg, G, c;
    __host__ __device__ void init(int M, int N, int G_, int c_) { nM = M / BM; nN = N / BM; nwg = nM * nN; G = G_; c = c_; }
    __host__ __device__ bool next(int i, Unit& u) const {
        const long L = (long)i * G + c; if (L >= nwg) return false;
        int wgid = (int)L; { const int q = nwg / NXCD, r = nwg % NXCD, xcd = wgid % NXCD, off = wgid / NXCD; wgid = (xcd < r ? xcd * (q + 1) : r * (q + 1) + (xcd - r) * q) + off; }
        const int nig = WGM * nN, gid = wgid / nig, fm = gid * WGM, gsz = (nM - fm) < WGM ? (nM - fm) : WGM;
        u.pm = fm + ((wgid % nig) % gsz); u.pn = (wgid % nig) / gsz; return true;
    }
};

struct ProbPlain { const bf16_t* A; const bf16_t* Bt; int lda, ldb, K;
    __device__ __forceinline__ const char* a_base(const Unit& u) const { return (const char*)(A + (size_t)u.pm * BM * lda); }
    __device__ __forceinline__ const char* b_base(const Unit& u) const { return (const char*)(Bt + (size_t)u.pn * BM * ldb); } };
struct ProbQK { const bf16_t* A; const bf16_t* Bt; int lda, ldb, K;
    __device__ __forceinline__ const char* a_base(const Unit& u) const { return (const char*)(A + (size_t)u.pm * BM * lda + u.pn * 256); }
    __device__ __forceinline__ const char* b_base(const Unit& u) const { return (const char*)(Bt + (size_t)(u.pm >> 5) * 256 * ldb + u.pn * 256); } };
struct ProbPV { const bf16_t* A; const bf16_t* Bt; int lda, ldb, K;
    __device__ __forceinline__ const char* a_base(const Unit& u) const { return (const char*)(A + (size_t)u.pm * BM * lda + u.pn * 256); }
    __device__ __forceinline__ const char* b_base(const Unit& u) const { return (const char*)(Bt + (size_t)((u.pm >> 5) * 4 + u.pn) * 256 * ldb); } };

typedef f32x4 Acc[2][2][4][2];

__device__ __forceinline__ void store8_bf16(bf16_t* p, f32x4 v0, f32x4 v1) {
    u32x4 w; w.x = cvt_pk_bf16(v0[0], v0[1]); w.y = cvt_pk_bf16(v0[2], v0[3]); w.z = cvt_pk_bf16(v1[0], v1[1]); w.w = cvt_pk_bf16(v1[2], v1[3]);
    *(u32x4*)p = w;
}

struct EpiBf16 { static constexpr bool PERM = true; bf16_t* O; int ldc;
    __device__ __forceinline__ void operator()(Acc& acc, const Unit& u, int wr, int wc, int fr, int fq) const {
        const int row0 = u.pm * BM + wr * 64 + fr, col0 = u.pn * BM + wc * 32 + 8 * fq;
#pragma unroll
        for (int ai = 0; ai < 2; ++ai)
#pragma unroll
            for (int m = 0; m < 4; ++m) { bf16_t* rowp = O + (size_t)(row0 + ai * HALF + m * 16) * ldc + col0;
#pragma unroll
                for (int bj = 0; bj < 2; ++bj) store8_bf16(rowp + bj * HALF, acc[ai][bj][m][0], acc[ai][bj][m][1]); }
    }
};
struct EpiZ { static constexpr bool PERM = true; bf16_t* Z; float* LR;
    __device__ __forceinline__ void operator()(Acc& acc, const Unit& u, int wr, int wc, int fr, int fq) const {
        const int row0 = u.pm * BM + wr * 64 + fr;
        if (u.pn < 12) {
            const int col0 = u.pn * BM + wc * 32 + 8 * fq;
#pragma unroll
            for (int ai = 0; ai < 2; ++ai)
#pragma unroll
                for (int m = 0; m < 4; ++m) { bf16_t* rowp = Z + (size_t)(row0 + ai * HALF + m * 16) * NZ + col0;
#pragma unroll
                    for (int bj = 0; bj < 2; ++bj) store8_bf16(rowp + bj * HALF, acc[ai][bj][m][0], acc[ai][bj][m][1]); }
        } else if (wc == 0) {
#pragma unroll
            for (int ai = 0; ai < 2; ++ai)
#pragma unroll
                for (int m = 0; m < 4; ++m) { float* p = LR + (size_t)(row0 + ai * HALF + m * 16) * 32 + 8 * fq;
                    *(f32x4*)p = acc[ai][0][m][0]; *(f32x4*)(p + 4) = acc[ai][0][m][1]; }
        }
    }
};
struct EpiKV { static constexpr bool PERM = true; bf16_t* Kmem; bf16_t* Vt;
    __device__ __forceinline__ void operator()(Acc& acc, const Unit& u, int wr, int wc, int fr, int fq) const {
        if (u.pn < 4) {
            const int row0 = u.pm * BM + wr * 64 + fr, col0 = u.pn * BM + wc * 32 + 8 * fq;
#pragma unroll
            for (int ai = 0; ai < 2; ++ai)
#pragma unroll
                for (int m = 0; m < 4; ++m) { bf16_t* rowp = Kmem + (size_t)(row0 + ai * HALF + m * 16) * 1024 + col0;
#pragma unroll
                    for (int bj = 0; bj < 2; ++bj) store8_bf16(rowp + bj * HALF, acc[ai][bj][m][0], acc[ai][bj][m][1]); }
        } else {
            bf16_t* vb = Vt + (size_t)(u.pm * 4 + (u.pn - 4)) * 256 * 256;
#pragma unroll
            for (int ai = 0; ai < 2; ++ai)
#pragma unroll
                for (int m = 0; m < 4; ++m) { const int key = ai * HALF + wr * 64 + m * 16 + fr;
#pragma unroll
                    for (int bj = 0; bj < 2; ++bj) { const int dim0 = bj * HALF + wc * 32 + 8 * fq;
#pragma unroll
                        for (int n = 0; n < 2; ++n) { const f32x4 v = acc[ai][bj][m][n]; const unsigned a = cvt_pk_bf16(v[0], v[1]), b = cvt_pk_bf16(v[2], v[3]);
                            bf16_t* q = vb + (size_t)(dim0 + 4 * n) * 256 + key;
                            q[0] = (bf16_t)(a & 0xffffu); q[256] = (bf16_t)(a >> 16); q[512] = (bf16_t)(b & 0xffffu); q[768] = (bf16_t)(b >> 16); } } }
        }
    }
};
template <bool NORM> struct EpiRes { static constexpr bool PERM = false; const float* base; float* out; const float* gain; bf16_t* XN; float* SSQ;
    __device__ __forceinline__ void operator()(Acc& acc, const Unit& u, int wr, int wc, int fr, int fq) const {
        const int row0 = u.pm * BM + wr * 64 + fr, col0 = u.pn * BM + wc * 32 + 4 * fq;
        f32x4 gv[2][2];
        if (NORM) {
#pragma unroll
            for (int bj = 0; bj < 2; ++bj)
#pragma unroll
                for (int n = 0; n < 2; ++n) gv[bj][n] = *(const f32x4*)(gain + col0 + bj * HALF + n * 16);
        }
#pragma unroll
        for (int ai = 0; ai < 2; ++ai)
#pragma unroll
            for (int m = 0; m < 4; ++m) { const int row = row0 + ai * HALF + m * 16; const size_t off = (size_t)row * D + col0; float ss = 0.f;
#pragma unroll
                for (int bj = 0; bj < 2; ++bj)
#pragma unroll
                    for (int n = 0; n < 2; ++n) { const f32x4 v = *(const f32x4*)(base + off + bj * HALF + n * 16) + acc[ai][bj][m][n];
                        *(f32x4*)(out + off + bj * HALF + n * 16) = v;
                        if (NORM) { ss += (v[0] * v[0] + v[1] * v[1]) + (v[2] * v[2] + v[3] * v[3]); const f32x4 w = v * gv[bj][n];
                            u32x2 pk; pk.x = cvt_pk_bf16(w[0], w[1]); pk.y = cvt_pk_bf16(w[2], w[3]); *(u32x2*)(XN + off + bj * HALF + n * 16) = pk; } }
                if (NORM) { ss += __shfl_xor(ss, 16); ss += __shfl_xor(ss, 32); if (fq == 0) SSQ[(size_t)row * 16 + u.pn * 4 + wc] = ss; }
                if (m & 1) asm volatile("" ::: "memory"); }
    }
};
template <int ACT> struct EpiScale { static constexpr bool PERM = true; bf16_t* O; int ldc; const float* SSQ; float post;
    __device__ __forceinline__ void operator()(Acc& acc, const Unit& u, int wr, int wc, int fr, int fq) const {
        const int row0 = u.pm * BM + wr * 64 + fr, col0 = u.pn * BM + wc * 32 + 8 * fq;
#pragma unroll
        for (int ai = 0; ai < 2; ++ai)
#pragma unroll
            for (int m = 0; m < 4; ++m) { const int row = row0 + ai * HALF + m * 16; const f32x4* sp = (const f32x4*)(SSQ + (size_t)row * 16);
                const f32x4 s4 = (sp[0] + sp[1]) + (sp[2] + sp[3]); const float s = (s4[0] + s4[1]) + (s4[2] + s4[3]);
                const float rs = rsqrtf(s * (1.0f / D) + EPS) * post; bf16_t* rowp = O + (size_t)row * ldc + col0;
#pragma unroll
                for (int bj = 0; bj < 2; ++bj) { f32x4 v0 = acc[ai][bj][m][0] * rs, v1 = acc[ai][bj][m][1] * rs;
                    if (ACT == 1) {
#pragma unroll
                        for (int i = 0; i < 4; ++i) { const float a = fmaxf(v0[i], 0.f), b = fmaxf(v1[i], 0.f); v0[i] = a * a; v1[i] = b * b; } }
                    store8_bf16(rowp + bj * HALF, v0, v1); } }
    }
};
struct EpiSoftmax { static constexpr bool PERM = true; bf16_t* P; int ldc; LAS float* red;
    __device__ __forceinline__ void operator()(Acc& acc, const Unit& u, int wr, int wc, int fr, int fq) const {
        LAS float* red0 = red; LAS float* red1 = red + 1024;
#pragma unroll
        for (int ai = 0; ai < 2; ++ai)
#pragma unroll
            for (int m = 0; m < 4; ++m) { float mx = -3.0e38f;
#pragma unroll
                for (int bj = 0; bj < 2; ++bj)
#pragma unroll
                    for (int n = 0; n < 2; ++n) { const f32x4 v = acc[ai][bj][m][n]; mx = fmaxf(mx, fmaxf(fmaxf(v[0], v[1]), fmaxf(v[2], v[3]))); }
                mx = fmaxf(mx, __shfl_xor(mx, 16)); mx = fmaxf(mx, __shfl_xor(mx, 32));
                if (fq == 0) red0[(ai * HALF + wr * 64 + m * 16 + fr) * 4 + wc] = mx; }
        LDS_WAIT(); __builtin_amdgcn_s_barrier(); asm volatile("" ::: "memory");
#pragma unroll
        for (int ai = 0; ai < 2; ++ai)
#pragma unroll
            for (int m = 0; m < 4; ++m) { const int r = ai * HALF + wr * 64 + m * 16 + fr; const f32x4 q = *(const LAS f32x4*)(red0 + r * 4);
                const float M = fmaxf(fmaxf(q[0], q[1]), fmaxf(q[2], q[3])); float s = 0.f;
#pragma unroll
                for (int bj = 0; bj < 2; ++bj)
#pragma unroll
                    for (int n = 0; n < 2; ++n) { f32x4 v = acc[ai][bj][m][n];
#pragma unroll
                        for (int i = 0; i < 4; ++i) { v[i] = __expf(v[i] - M); s += v[i]; }
                        acc[ai][bj][m][n] = v; }
                s += __shfl_xor(s, 16); s += __shfl_xor(s, 32);
                if (fq == 0) red1[r * 4 + wc] = s; }
        LDS_WAIT(); __builtin_amdgcn_s_barrier(); asm volatile("" ::: "memory");
        const int row0 = u.pm * BM + wr * 64 + fr, col0 = u.pn * BM + wc * 32 + 8 * fq;
#pragma unroll
        for (int ai = 0; ai < 2; ++ai)
#pragma unroll
            for (int m = 0; m < 4; ++m) { const int r = ai * HALF + wr * 64 + m * 16 + fr; const f32x4 q = *(const LAS f32x4*)(red1 + r * 4);
                const float inv = 1.0f / ((q[0] + q[1]) + (q[2] + q[3])); bf16_t* rowp = P + (size_t)(row0 + ai * HALF + m * 16) * ldc + col0;
#pragma unroll
                for (int bj = 0; bj < 2; ++bj) store8_bf16(rowp + bj * HALF, acc[ai][bj][m][0] * inv, acc[ai][bj][m][1] * inv); }
    }
};

template <class Epi, class Prob, class Sched, bool ALIGN_EPI>
__device__ __forceinline__ void gemm_phase(LAS unsigned char* lds, int tid, int wid, const Prob g, const Sched& S, const Epi& E) {
    const int lane = tid & 63, wr = wid >> 2, wc = wid & 3, fr = lane & 15, fq = lane >> 4;
    const int K = g.K, nt = K / BK;
    unsigned voffA[2], voffB[2];
#pragma unroll
    for (int i = 0; i < 2; ++i) { int R, C; stage_rc(tid * 16 + i * 8192, R, C); const int Rb = Epi::PERM ? ((R & ~31) + perm32(R & 31)) : R;
        voffA[i] = (unsigned)(R * g.lda + C) * 2u; voffB[i] = (unsigned)(Rb * g.ldb + C) * 2u; }
    const size_t kstep = (size_t)(BK * 2);
    const size_t hstepA = (size_t)HALF * g.lda * 2, hstepB = (size_t)HALF * g.ldb * 2;
    const unsigned ldsw = (unsigned)wid * 1024u;
    const int aoff = lds_byte(wr * 64 + fr, fq * 8), boff = lds_byte(wc * 32 + fr, fq * 8);
#define PG8_SA(b, h) (((b) * 2 + (h)) * HTB)
#define PG8_SB(b, h) ((4 + (b) * 2 + (h)) * HTB)
#define PG8_STAGE(bufoff, gbase, voff) do { _Pragma("unroll") for (int _i = 0; _i < 2; ++_i) \
        __builtin_amdgcn_global_load_lds((const unsigned*)((const char*)(gbase) + (voff)[_i]), (LAS unsigned*)(lds + (bufoff) + ldsw + _i * 8192), 16, 0, 0); } while (0)
#define PG8_LDA(dst, b, h) do { _Pragma("unroll") for (int m = 0; m < 4; ++m) _Pragma("unroll") for (int k = 0; k < 2; ++k) dst[m][k] = *(const LAS bf16x8*)(lds + PG8_SA(b, h) + aoff + m * 2048 + k * 1024); } while (0)
#define PG8_LDB(dst, b, h) do { _Pragma("unroll") for (int n = 0; n < 2; ++n) _Pragma("unroll") for (int k = 0; k < 2; ++k) dst[n][k] = *(const LAS bf16x8*)(lds + PG8_SB(b, h) + boff + n * 2048 + k * 1024); } while (0)
#define PG8_MMA(ai, bj, At, Bt) do { __builtin_amdgcn_s_setprio(1); _Pragma("unroll") for (int m = 0; m < 4; ++m) _Pragma("unroll") for (int n = 0; n < 2; ++n) _Pragma("unroll") for (int k = 0; k < 2; ++k) \
        acc[ai][bj][m][n] = __builtin_amdgcn_mfma_f32_16x16x32_bf16(Bt[n][k], At[m][k], acc[ai][bj][m][n], 0, 0, 0); __builtin_amdgcn_s_setprio(0); } while (0)
#define PG8_WAIT_V(n) asm volatile("s_waitcnt vmcnt(" #n ")" ::: "memory")
#define PG8_WAIT_L(n) asm volatile("s_waitcnt lgkmcnt(" #n ")" ::: "memory")
#define PG8_BAR __builtin_amdgcn_s_barrier()
#define PG8_SCHED __builtin_amdgcn_sched_barrier(0)
    Unit cur, nxt; int ui = 0;
    if (!S.next(0, cur)) return;
    Acc acc;
#pragma unroll
    for (int a = 0; a < 2; ++a)
#pragma unroll
        for (int b = 0; b < 2; ++b)
#pragma unroll
            for (int m = 0; m < 4; ++m)
#pragma unroll
                for (int n = 0; n < 2; ++n) acc[a][b][m][n] = (f32x4){0.f, 0.f, 0.f, 0.f};
    bf16x8 At[4][2], B0[2][2], B1[2][2];
    const char* cA = g.a_base(cur); const char* cB = g.b_base(cur);
    PG8_STAGE(PG8_SB(0, 0), cB, voffB); PG8_STAGE(PG8_SB(0, 1), cB + hstepB, voffB); PG8_STAGE(PG8_SA(0, 0), cA, voffA); PG8_STAGE(PG8_SA(0, 1), cA + hstepA, voffA);
    if (wr == 1) PG8_BAR;
    PG8_WAIT_V(2); PG8_BAR;
    PG8_STAGE(PG8_SB(1, 0), cB + kstep, voffB); PG8_STAGE(PG8_SA(1, 0), cA + kstep, voffA); PG8_STAGE(PG8_SB(1, 1), cB + hstepB + kstep, voffB);
    PG8_WAIT_V(6); PG8_BAR;
    for (;;) {
        const bool has_next = S.next(ui + 1, nxt);
        const char* nA = has_next ? g.a_base(nxt) : cA; const char* nB = has_next ? g.b_base(nxt) : cB;
#pragma nounroll
        for (int t = 0; t < nt; t += 2) {
            const bool last = (t == nt - 2);
            const char* a1 = cA + (size_t)(t + 1) * kstep;
            const char* a2 = last ? nA : cA + (size_t)(t + 2) * kstep; const char* b2 = last ? nB : cB + (size_t)(t + 2) * kstep;
            const char* a3 = a2 + kstep; const char* b3 = b2 + kstep;
            PG8_LDB(B0, 0, 0); PG8_LDB(B1, 0, 1); PG8_SCHED; PG8_LDA(At, 0, 0); PG8_STAGE(PG8_SA(1, 1), a1 + hstepA, voffA);
            PG8_WAIT_V(8); PG8_WAIT_L(0); PG8_BAR; PG8_MMA(0, 0, At, B0); PG8_MMA(0, 1, At, B1); PG8_BAR; PG8_SCHED;
            PG8_LDA(At, 0, 1); PG8_STAGE(PG8_SB(0, 0), b2, voffB); PG8_STAGE(PG8_SB(0, 1), b2 + hstepB, voffB); PG8_STAGE(PG8_SA(0, 0), a2, voffA);
            PG8_WAIT_V(8); PG8_WAIT_L(0); PG8_BAR; PG8_MMA(1, 0, At, B0); PG8_MMA(1, 1, At, B1); PG8_BAR; PG8_SCHED;
            PG8_LDB(B0, 1, 0); PG8_LDB(B1, 1, 1); PG8_SCHED; PG8_LDA(At, 1, 0); PG8_STAGE(PG8_SA(0, 1), a2 + hstepA, voffA);
            PG8_WAIT_V(8); PG8_WAIT_L(0); PG8_BAR; PG8_MMA(0, 0, At, B0); PG8_MMA(0, 1, At, B1); PG8_BAR; PG8_SCHED;
            PG8_LDA(At, 1, 1); PG8_STAGE(PG8_SB(1, 0), b3, voffB); PG8_STAGE(PG8_SB(1, 1), b3 + hstepB, voffB); PG8_STAGE(PG8_SA(1, 0), a3, voffA);
            PG8_WAIT_V(8); PG8_WAIT_L(0); PG8_BAR; PG8_MMA(1, 0, At, B0); PG8_MMA(1, 1, At, B1); PG8_BAR; PG8_SCHED;
        }
        if constexpr (ALIGN_EPI) { if (wr == 0) PG8_BAR; }
        E(acc, cur, wr, wc, fr, fq);
        if (!has_next) break;
#pragma unroll
        for (int a = 0; a < 2; ++a)
#pragma unroll
            for (int b = 0; b < 2; ++b)
#pragma unroll
                for (int m = 0; m < 4; ++m)
#pragma unroll
                    for (int n = 0; n < 2; ++n) acc[a][b][m][n] = (f32x4){0.f, 0.f, 0.f, 0.f};
        cur = nxt; cA = nA; cB = nB; ++ui;
        if constexpr (ALIGN_EPI) { if (wr == 1) PG8_BAR; }
    }
    PG8_WAIT_V(0);
    if constexpr (!ALIGN_EPI) { if (wr == 0) PG8_BAR; }
    PG8_BAR;
#undef PG8_SA
#undef PG8_SB
#undef PG8_STAGE
#undef PG8_LDA
#undef PG8_LDB
#undef PG8_MMA
#undef PG8_WAIT_V
#undef PG8_WAIT_L
#undef PG8_BAR
#undef PG8_SCHED
}
}

struct Args { const float* in[21]; float* out; unsigned char* ws; int ph_lo, ph_hi; };
enum { I_X = 0, I_MEM, I_MIXN, I_WIN, I_CONVW, I_CONVN, I_WAF, I_BAF, I_WAB, I_BAB, I_GLAN, I_WOUT, I_XAN, I_MEMN, I_WXQ, I_WXKV, I_WXO, I_MLPN, I_WUP, I_WDN, I_FINN };
constexpr int N_PHASES = 13;

struct Ctx { LAS unsigned char* lds; int tid, lane, wave, gw, NGW, G; };

__device__ __forceinline__ void p0_transpose_item(const float* W, int K, int N, bf16_t* WT, LAS float* scr, int item, int lane) {
    const int nblk = N / 32, kb = item / nblk, nb = item % nblk, k0 = 64 * kb, n0 = 32 * nb;
#pragma unroll 8
    for (int i = 0; i < 32; ++i) { const int kk = 2 * i + (lane >> 5); scr[kk * 33 + (lane & 31)] = W[(size_t)(k0 + kk) * N + n0 + (lane & 31)]; }
    LDS_WAIT(); asm volatile("" ::: "memory");
    const int c = lane & 7;
#pragma unroll
    for (int j = 0; j < 4; ++j) { const int n = (lane >> 3) + 8 * j; const LAS float* s = scr + (8 * c) * 33 + n;
        u32x4 o; o.x = cvt_pk_bf16(s[0 * 33], s[1 * 33]); o.y = cvt_pk_bf16(s[2 * 33], s[3 * 33]); o.z = cvt_pk_bf16(s[4 * 33], s[5 * 33]); o.w = cvt_pk_bf16(s[6 * 33], s[7 * 33]);
        *(u32x4*)(WT + (size_t)(n0 + n) * K + k0 + 8 * c) = o; }
    LDS_WAIT(); asm volatile("" ::: "memory");
}
__device__ __forceinline__ void rms_row_to_bf16(const float* xrow, const float* gain, bf16_t* orow, int lane) {
    const f32x4* xr = (const f32x4*)xrow + lane; const f32x4* gr = (const f32x4*)gain + lane;
    f32x4 v[4]; float s = 0.f;
#pragma unroll
    for (int j = 0; j < 4; ++j) { v[j] = xr[64 * j]; s += (v[j][0] * v[j][0] + v[j][1] * v[j][1]) + (v[j][2] * v[j][2] + v[j][3] * v[j][3]); }
    const float rstd = rsqrtf(wave_sum(s) * (1.f / D) + EPS);
    u32x2* o8 = (u32x2*)orow + lane;
#pragma unroll
    for (int j = 0; j < 4; ++j) { const f32x4 w = v[j] * rstd * gr[64 * j]; u32x2 pk; pk.x = cvt_pk_bf16(w[0], w[1]); pk.y = cvt_pk_bf16(w[2], w[3]); o8[64 * j] = pk; }
}
__device__ __forceinline__ void phase_prologue(const Ctx& c, const Args& a) {
    unsigned char* ws = a.ws;
    LAS float* scr = (LAS float*)(c.lds + c.wave * 16384);
    struct WD { const float* W; int K, N; size_t off; };
    const WD wd[7] = { {a.in[I_WIN], D, WIN, WS_WIN}, {a.in[I_WOUT], D, D, WS_WOUT}, {a.in[I_WXQ], D, D, WS_WXQ}, {a.in[I_WXKV], D, 2 * D, WS_WXKV},
                       {a.in[I_WXO], D, D, WS_WXO}, {a.in[I_WUP], D, FF, WS_WUP}, {a.in[I_WDN], FF, D, WS_WDN} };
#pragma unroll
    for (int w = 0; w < 7; ++w) { const int nitems = (wd[w].K / 64) * (wd[w].N / 32);
        for (int it = c.gw; it < nitems; it += c.NGW) p0_transpose_item(wd[w].W, wd[w].K, wd[w].N, (bf16_t*)(ws + wd[w].off), scr, it, c.lane); }
    { u32x4* z = (u32x4*)(ws + WS_WIN + (size_t)WIN * D * 2); const int n16 = (NZP - WIN) * D * 2 / 16;
      for (int i = c.gw * 64 + c.lane; i < n16; i += c.NGW * 64) z[i] = (u32x4){0u, 0u, 0u, 0u}; }
    for (int m = c.gw; m < T; m += c.NGW) rms_row_to_bf16(a.in[I_X] + (size_t)m * D, a.in[I_MIXN], (bf16_t*)(ws + WS_XN) + (size_t)m * D, c.lane);
    for (int m = c.gw; m < MROWS; m += c.NGW) rms_row_to_bf16(a.in[I_MEM] + (size_t)m * D, a.in[I_MEMN], (bf16_t*)(ws + WS_MN) + (size_t)m * D, c.lane);
}

constexpr int GS = 144;
constexpr int L_QF = 0, L_KF = 9216, L_QB = 18432, L_KB = 27648, L_VT = 36864, L_AC = 55296, L_RED = 64512, L_WA = 66560, L_WB = 74752;
__device__ __forceinline__ bf16x8 gfrag(const LAS unsigned char* base, int r0, int ks, int fr, int fq) { return *(const LAS bf16x8*)(base + (r0 + fr) * GS + ks * 64 + fq * 16); }
__device__ __forceinline__ float logsig(float z) { return fminf(z, 0.f) - __logf(1.0f + __expf(-fabsf(z))); }

__device__ __forceinline__ void gla_load_w(const Ctx& c, const Args& a, int h) {
    const int idx = c.tid * 4, dir = idx >> 10, r = (idx >> 6) & 15, d = idx & 63;
    const float* src = (dir ? a.in[I_WAB] : a.in[I_WAF]) + r * 256 + h * 64 + d;
    *(LAS f32x4*)(c.lds + L_WA + idx * 4) = *(const f32x4*)src;
    if (c.tid < 32) { const int dr = c.tid >> 4, dd = (c.tid & 15) * 4; *(LAS f32x4*)(c.lds + L_WB + (dr * 64 + dd) * 4) = *(const f32x4*)((dr ? a.in[I_BAB] : a.in[I_BAF]) + h * 64 + dd); }
}
template <bool PASS_A>
__device__ __forceinline__ void gla_prep(const Ctx& c, const Args& a, int b, int h, int n, float* Gf, float* Gb) {
    const bf16_t* Z = (const bf16_t*)(a.ws + WS_Z); const float* LR = (const float*)(a.ws + WS_LR);
    const int t = c.lane, d0 = 8 * c.wave; const size_t row = (size_t)b * SEQ + n * 64 + t;
    const f32x4* lrp = (const f32x4*)(LR + row * 32);
    f32x4 l[8];
#pragma unroll
    for (int i = 0; i < 8; ++i) l[i] = lrp[i];
    const u32x4 qraw = *(const u32x4*)(Z + row * NZ + ZQ + h * 64 + d0), kraw = *(const u32x4*)(Z + row * NZ + ZK + h * 64 + d0);
    float qv[8], kv[8];
#pragma unroll
    for (int i = 0; i < 4; ++i) { qv[2 * i] = bf_lo(qraw[i]); qv[2 * i + 1] = bf_hi(qraw[i]); kv[2 * i] = bf_lo(kraw[i]); kv[2 * i + 1] = bf_hi(kraw[i]); }
    const LAS float* WA = (const LAS float*)(c.lds + L_WA); const LAS float* WB = (const LAS float*)(c.lds + L_WB);
    float zf[8], zb[8];
    { const f32x4 b0 = *(const LAS f32x4*)(WB + d0), b1 = *(const LAS f32x4*)(WB + d0 + 4), b2 = *(const LAS f32x4*)(WB + 64 + d0), b3 = *(const LAS f32x4*)(WB + 64 + d0 + 4);
#pragma unroll
      for (int i = 0; i < 4; ++i) { zf[i] = b0[i]; zf[4 + i] = b1[i]; zb[i] = b2[i]; zb[4 + i] = b3[i]; } }
#pragma unroll
    for (int r = 0; r < 16; ++r) {
        const f32x4 f0 = *(const LAS f32x4*)(WA + r * 64 + d0), f1 = *(const LAS f32x4*)(WA + r * 64 + d0 + 4);
        const f32x4 g0 = *(const LAS f32x4*)(WA + 1024 + r * 64 + d0), g1 = *(const LAS f32x4*)(WA + 1024 + r * 64 + d0 + 4);
        const float lf = l[r >> 2][r & 3], lb = l[4 + (r >> 2)][r & 3];
#pragma unroll
        for (int i = 0; i < 4; ++i) { zf[i] += lf * f0[i]; zf[4 + i] += lf * f1[i]; zb[i] += lb * g0[i]; zb[4 + i] += lb * g1[i]; }
        if (r & 1) {
#pragma unroll
            for (int i = 0; i < 8; ++i) asm volatile("" : "+v"(zf[i]), "+v"(zb[i])); }
    }
    float o0[8], o1[8], o2[8], o3[8];
#pragma unroll
    for (int i = 0; i < 8; ++i) {
        float bb = logsig(zf[i]) * (1.0f / 16.0f), cc = logsig(zb[i]) * (1.0f / 16.0f);
#pragma unroll
        for (int off = 1; off < 64; off <<= 1) { const float y = __shfl_up(bb, off); if (t >= off) bb += y; const float w = __shfl_down(cc, off); if (t + off < 64) cc += w; }
        if (PASS_A) {
            const float b63 = __shfl(bb, 63), c0 = __shfl(cc, 0);
            o0[i] = kv[i] * __expf(b63 - bb); o1[i] = kv[i] * __expf(c0 - cc);
            if (t == 63) Gf[d0 + i] = bb;
            if (t == 0) Gb[d0 + i] = cc;
        } else {
            const float eb = __expf(bb), ec = __expf(cc);
            o0[i] = qv[i] * 0.125f * eb; o1[i] = kv[i] * __expf(-bb); o2[i] = qv[i] * 0.125f * ec; o3[i] = kv[i] * __expf(-cc);
        }
    }
    if (PASS_A) {
#pragma unroll
        for (int i = 0; i < 8; i += 2) { const unsigned pf = cvt_pk_bf16(o0[i], o0[i + 1]), pb = cvt_pk_bf16(o1[i], o1[i + 1]);
            *(LAS bf16_t*)(c.lds + L_QF + (d0 + i) * GS + t * 2) = (bf16_t)(pf & 0xffffu); *(LAS bf16_t*)(c.lds + L_QF + (d0 + i + 1) * GS + t * 2) = (bf16_t)(pf >> 16);
            *(LAS bf16_t*)(c.lds + L_KF + (d0 + i) * GS + t * 2) = (bf16_t)(pb & 0xffffu); *(LAS bf16_t*)(c.lds + L_KF + (d0 + i + 1) * GS + t * 2) = (bf16_t)(pb >> 16); }
    } else {
        u32x4 w0, w1, w2, w3;
#pragma unroll
        for (int i = 0; i < 4; ++i) { w0[i] = cvt_pk_bf16(o0[2 * i], o0[2 * i + 1]); w1[i] = cvt_pk_bf16(o1[2 * i], o1[2 * i + 1]); w2[i] = cvt_pk_bf16(o2[2 * i], o2[2 * i + 1]); w3[i] = cvt_pk_bf16(o3[2 * i], o3[2 * i + 1]); }
        *(LAS u32x4*)(c.lds + L_QF + t * GS + d0 * 2) = w0; *(LAS u32x4*)(c.lds + L_KF + t * GS + d0 * 2) = w1;
        *(LAS u32x4*)(c.lds + L_QB + t * GS + d0 * 2) = w2; *(LAS u32x4*)(c.lds + L_KB + t * GS + d0 * 2) = w3;
    }
    const int e0 = 16 * c.wave; const u32x4* vp = (const u32x4*)(Z + row * NZ + ZV + h * 128 + e0);
    const u32x4 va = vp[0], vb = vp[1];
#pragma unroll
    for (int i = 0; i < 4; ++i) {
        *(LAS bf16_t*)(c.lds + L_VT + (e0 + 2 * i) * GS + t * 2) = (bf16_t)(va[i] & 0xffffu); *(LAS bf16_t*)(c.lds + L_VT + (e0 + 2 * i + 1) * GS + t * 2) = (bf16_t)(va[i] >> 16);
        *(LAS bf16_t*)(c.lds + L_VT + (e0 + 8 + 2 * i) * GS + t * 2) = (bf16_t)(vb[i] & 0xffffu); *(LAS bf16_t*)(c.lds + L_VT + (e0 + 8 + 2 * i + 1) * GS + t * 2) = (bf16_t)(vb[i] >> 16); }
}

__device__ __forceinline__ void phase_gla_a(const Ctx& c, const Args& a) {
    float* UU = (float*)(a.ws + WS_UU); float* GG = (float*)(a.ws + WS_GG);
    const int fr = c.lane & 15, fq = c.lane >> 4, w = c.wave;
    int h_loaded = -1;
    for (int uu = blockIdx.x; uu < NUNIT; uu += c.G) {
        const int h = uu & 3, n = (uu >> 2) & (NCH - 1), b = uu >> 9, unit = (b * GH + h) * NCH + n;
        __syncthreads();
        if (h != h_loaded) { gla_load_w(c, a, h); h_loaded = h; __syncthreads(); }
        gla_prep<true>(c, a, b, h, n, GG + (size_t)unit * 64, GG + (size_t)(NUNIT + unit) * 64);
        __syncthreads();
        bf16x8 av[2];
#pragma unroll
        for (int ks = 0; ks < 2; ++ks) av[ks] = gfrag(c.lds + L_VT, 16 * w, ks, fr, fq);
#pragma unroll
        for (int dir = 0; dir < 2; ++dir)
#pragma unroll
            for (int dt = 0; dt < 4; ++dt) { f32x4 acc = (f32x4){0.f, 0.f, 0.f, 0.f};
#pragma unroll
                for (int ks = 0; ks < 2; ++ks) acc = __builtin_amdgcn_mfma_f32_16x16x32_bf16(av[ks], gfrag(c.lds + (dir ? L_KF : L_QF), 16 * dt, ks, fr, fq), acc, 0, 0, 0);
                float* up = UU + ((size_t)(dir * NUNIT + unit) * 128 + 16 * w + 4 * fq) * 64 + 16 * dt + fr;
#pragma unroll
                for (int i = 0; i < 4; ++i) up[i * 64] = acc[i]; }
    }
}
constexpr int NSC = 16, SCN = 8;
constexpr int M_QF = 0, M_KF = 9216, M_QB = 18432, M_KB = 27648, M_QB2 = 36864, M_VT = 46080, M_AC = 64512, M_KHF = 73728, M_KHB = 82944, M_RED = 92160,
              M_WA = 94208, M_WB = 102400, M_GF = 102912, M_GB = 103168, M_LC = 103424;
constexpr size_t WS_RS = WS_SS;
constexpr size_t WS_TT = WS_UU;
constexpr size_t WS_LC = WS_GG;
constexpr size_t WS_AFB = WS_GG + 512 * 1024;

__device__ __forceinline__ float wave_prefix_sum(float v) {
#define DPP_ADD(ctrl, rmask) v += __int_as_float(__builtin_amdgcn_update_dpp(0, __float_as_int(v), ctrl, rmask, 0xf, false))
    DPP_ADD(0x111, 0xf); DPP_ADD(0x112, 0xf); DPP_ADD(0x114, 0xf); DPP_ADD(0x118, 0xf); DPP_ADD(0x142, 0xa); DPP_ADD(0x143, 0xc);
#undef DPP_ADD
    return v;
}
__device__ __forceinline__ void gla_load_w2(const Ctx& c, const Args& a, int h) {
    const int idx = c.tid * 4, dir = idx >> 10, r = (idx >> 6) & 15, d = idx & 63;
    const float* src = (dir ? a.in[I_WAB] : a.in[I_WAF]) + r * 256 + h * 64 + d;
    *(LAS f32x4*)(c.lds + M_WA + idx * 4) = *(const f32x4*)src;
    if (c.tid < 32) { const int dr = c.tid >> 4, dd = (c.tid & 15) * 4; *(LAS f32x4*)(c.lds + M_WB + (dr * 64 + dd) * 4) = *(const f32x4*)((dr ? a.in[I_BAB] : a.in[I_BAF]) + h * 64 + dd); }
}
struct PrepIn { f32x4 l[8]; u32x4 q, k, va, vb; };
__device__ __forceinline__ void gla_prep_load(PrepIn& in, const Ctx& c, const Args& a, int b, int h, int chunk) {
    const bf16_t* Z = (const bf16_t*)(a.ws + WS_Z); const float* LR = (const float*)(a.ws + WS_LR);
    const size_t row = (size_t)b * SEQ + chunk * 64 + c.lane; const f32x4* lrp = (const f32x4*)(LR + row * 32);
#pragma unroll
    for (int i = 0; i < 8; ++i) in.l[i] = lrp[i];
    in.q = *(const u32x4*)(Z + row * NZ + ZQ + h * 64 + 8 * c.wave); in.k = *(const u32x4*)(Z + row * NZ + ZK + h * 64 + 8 * c.wave);
    const u32x4* vp = (const u32x4*)(Z + row * NZ + ZV + h * 128 + 16 * c.wave); in.va = vp[0]; in.vb = vp[1];
}
template <bool MODE_A>
__device__ __forceinline__ void gla_prep2(const Ctx& c, const PrepIn& in, const f32x4 lc0, const f32x4 lc1) {
    const int t = c.lane, d0 = 8 * c.wave;
    float qv[8], kv[8];
#pragma unroll
    for (int i = 0; i < 4; ++i) { qv[2 * i] = bf_lo(in.q[i]); qv[2 * i + 1] = bf_hi(in.q[i]); kv[2 * i] = bf_lo(in.k[i]); kv[2 * i + 1] = bf_hi(in.k[i]); }
    const LAS float* WA = (const LAS float*)(c.lds + M_WA); const LAS float* WB = (const LAS float*)(c.lds + M_WB);
    float zf[8], zb[8];
    { const f32x4 b0 = *(const LAS f32x4*)(WB + d0), b1 = *(const LAS f32x4*)(WB + d0 + 4), b2 = *(const LAS f32x4*)(WB + 64 + d0), b3 = *(const LAS f32x4*)(WB + 64 + d0 + 4);
#pragma unroll
      for (int i = 0; i < 4; ++i) { zf[i] = b0[i]; zf[4 + i] = b1[i]; zb[i] = b2[i]; zb[4 + i] = b3[i]; } }
#pragma unroll
    for (int r = 0; r < 16; ++r) {
        const f32x4 f0 = *(const LAS f32x4*)(WA + r * 64 + d0), f1 = *(const LAS f32x4*)(WA + r * 64 + d0 + 4);
        const f32x4 g0 = *(const LAS f32x4*)(WA + 1024 + r * 64 + d0), g1 = *(const LAS f32x4*)(WA + 1024 + r * 64 + d0 + 4);
        const float lf = in.l[r >> 2][r & 3], lb = in.l[4 + (r >> 2)][r & 3];
#pragma unroll
        for (int i = 0; i < 4; ++i) { zf[i] += lf * f0[i]; zf[4 + i] += lf * f1[i]; zb[i] += lb * g0[i]; zb[4 + i] += lb * g1[i]; }
        if (r & 1) {
#pragma unroll
            for (int i = 0; i < 8; ++i) asm volatile("" : "+v"(zf[i]), "+v"(zb[i])); }
    }
    float o0[8], o1[8], o2[8], o3[8], o4[8], o5[8], gft[8], gbt[8];
#pragma unroll
    for (int i = 0; i < 8; ++i) {
        const float laf = logsig(zf[i]) * (1.0f / 16.0f), lab = logsig(zb[i]) * (1.0f / 16.0f);
        const float pf = wave_prefix_sum(laf), pb = wave_prefix_sum(lab);
        const float Gf = __int_as_float(__builtin_amdgcn_readlane(__float_as_int(pf), 63)), Gb = __int_as_float(__builtin_amdgcn_readlane(__float_as_int(pb), 63));
        gft[i] = Gf; gbt[i] = Gb;
        o4[i] = kv[i] * __expf(Gf - pf);
        if (MODE_A) { o5[i] = kv[i] * __expf(pb - lab); }
        else { const float cc = Gb - pb + lab, lcv = (i < 4) ? lc0[i & 3] : lc1[i & 3], q8 = qv[i] * 0.125f;
            o0[i] = q8 * __expf(pf); o1[i] = kv[i] * __expf(-pf); o2[i] = q8 * __expf(cc); o3[i] = kv[i] * __expf(-cc); o5[i] = q8 * __expf(cc + lcv); }
    }
#pragma unroll
    for (int i = 0; i < 8; i += 2) { const unsigned pf = cvt_pk_bf16(o4[i], o4[i + 1]);
        *(LAS bf16_t*)(c.lds + M_KHF + (d0 + i) * GS + t * 2) = (bf16_t)(pf & 0xffffu); *(LAS bf16_t*)(c.lds + M_KHF + (d0 + i + 1) * GS + t * 2) = (bf16_t)(pf >> 16);
        if (MODE_A) { const unsigned pb = cvt_pk_bf16(o5[i], o5[i + 1]);
            *(LAS bf16_t*)(c.lds + M_KHB + (d0 + i) * GS + t * 2) = (bf16_t)(pb & 0xffffu); *(LAS bf16_t*)(c.lds + M_KHB + (d0 + i + 1) * GS + t * 2) = (bf16_t)(pb >> 16); } }
    if (!MODE_A) {
        u32x4 w0, w1, w2, w3, w4;
#pragma unroll
        for (int i = 0; i < 4; ++i) { w0[i] = cvt_pk_bf16(o0[2 * i], o0[2 * i + 1]); w1[i] = cvt_pk_bf16(o1[2 * i], o1[2 * i + 1]); w2[i] = cvt_pk_bf16(o2[2 * i], o2[2 * i + 1]);
                                      w3[i] = cvt_pk_bf16(o3[2 * i], o3[2 * i + 1]); w4[i] = cvt_pk_bf16(o5[2 * i], o5[2 * i + 1]); }
        *(LAS u32x4*)(c.lds + M_QF + t * GS + d0 * 2) = w0; *(LAS u32x4*)(c.lds + M_KF + t * GS + d0 * 2) = w1;
        *(LAS u32x4*)(c.lds + M_QB + t * GS + d0 * 2) = w2; *(LAS u32x4*)(c.lds + M_KB + t * GS + d0 * 2) = w3; *(LAS u32x4*)(c.lds + M_QB2 + t * GS + d0 * 2) = w4;
    }
    if (t == 63) { *(LAS f32x4*)(c.lds + M_GF + d0 * 4) = (f32x4){gft[0], gft[1], gft[2], gft[3]}; *(LAS f32x4*)(c.lds + M_GF + d0 * 4 + 16) = (f32x4){gft[4], gft[5], gft[6], gft[7]};
        if (MODE_A) { *(LAS f32x4*)(c.lds + M_GB + d0 * 4) = (f32x4){gbt[0], gbt[1], gbt[2], gbt[3]}; *(LAS f32x4*)(c.lds + M_GB + d0 * 4 + 16) = (f32x4){gbt[4], gbt[5], gbt[6], gbt[7]}; } }
    const int e0 = 16 * c.wave;
#pragma unroll
    for (int i = 0; i < 4; ++i) {
        *(LAS bf16_t*)(c.lds + M_VT + (e0 + 2 * i) * GS + t * 2) = (bf16_t)(in.va[i] & 0xffffu); *(LAS bf16_t*)(c.lds + M_VT + (e0 + 2 * i + 1) * GS + t * 2) = (bf16_t)(in.va[i] >> 16);
        *(LAS bf16_t*)(c.lds + M_VT + (e0 + 8 + 2 * i) * GS + t * 2) = (bf16_t)(in.vb[i] & 0xffffu); *(LAS bf16_t*)(c.lds + M_VT + (e0 + 8 + 2 * i + 1) * GS + t * 2) = (bf16_t)(in.vb[i] >> 16); }
}
#define GLA_BAR() do { LDS_WAIT(); __builtin_amdgcn_s_barrier(); asm volatile("" ::: "memory"); } while (0)
__device__ __forceinline__ f32x4 exp4(f32x4 v) { return (f32x4){__expf(v[0]), __expf(v[1]), __expf(v[2]), __expf(v[3])}; }
__device__ __forceinline__ bf16x8 pack_frag(f32x4 lo, f32x4 hi) { u32x4 w; w.x = cvt_pk_bf16(lo[0], lo[1]); w.y = cvt_pk_bf16(lo[2], lo[3]); w.z = cvt_pk_bf16(hi[0], hi[1]); w.w = cvt_pk_bf16(hi[2], hi[3]); return __builtin_bit_cast(bf16x8, w); }

__device__ __forceinline__ void phase_gla_A2(const Ctx& c, const Args& a) {
    bf16_t* RS = (bf16_t*)(a.ws + WS_RS); float* TT = (float*)(a.ws + WS_TT); float* LCg = (float*)(a.ws + WS_LC); float* AFB = (float*)(a.ws + WS_AFB);
    const int fr = c.lane & 15, fq = c.lane >> 4, w = c.wave;
    int h_loaded = -1;
    for (int uu = blockIdx.x; uu < BATCH * GH * NSC; uu += c.G) {
        const int h = uu & 3, sc = (uu >> 2) & (NSC - 1), b = uu >> 6, bh = b * GH + h, u16 = bh * NSC + sc;
        __syncthreads();
        if (h != h_loaded) { gla_load_w2(c, a, h); h_loaded = h; }
        if (c.tid < 64) *(LAS float*)(c.lds + M_LC + c.tid * 4) = 0.f;
        __syncthreads();
        f32x4 Tf[4], Tb[4], Lf[4];
#pragma unroll
        for (int dt = 0; dt < 4; ++dt) { Tf[dt] = (f32x4){0.f, 0.f, 0.f, 0.f}; Tb[dt] = Tf[dt]; Lf[dt] = Tf[dt]; }
        PrepIn in; gla_prep_load(in, c, a, b, h, sc * SCN + SCN - 1);
        for (int n = SCN - 1; n >= 0; --n) {
            const int chunk = sc * SCN + n; const size_t cg_ = (size_t)bh * NCH + chunk;
            gla_prep2<true>(c, in, (f32x4){0.f, 0.f, 0.f, 0.f}, (f32x4){0.f, 0.f, 0.f, 0.f});
            if (n > 0) gla_prep_load(in, c, a, b, h, chunk - 1);
            GLA_BAR();
#pragma unroll
            for (int dt = 0; dt < 4; ++dt) { u32x2 pk; pk.x = cvt_pk_bf16(Tb[dt][0], Tb[dt][1]); pk.y = cvt_pk_bf16(Tb[dt][2], Tb[dt][3]);
                *(u32x2*)(RS + (cg_ * 128 + 16 * w + fr) * 64 + 16 * dt + 4 * fq) = pk; }
            if (c.tid < 64) { LAS float* lcs = (LAS float*)(c.lds + M_LC) + c.tid; const float v = *lcs; LCg[cg_ * 64 + c.tid] = v; *lcs = v + *((const LAS float*)(c.lds + M_GB) + c.tid); }
            bf16x8 bv[2];
#pragma unroll
            for (int ks = 0; ks < 2; ++ks) bv[ks] = gfrag(c.lds + M_VT, 16 * w, ks, fr, fq);
#pragma unroll
            for (int dt = 0; dt < 4; ++dt) { f32x4 uf = (f32x4){0.f, 0.f, 0.f, 0.f}, ub = uf;
#pragma unroll
                for (int ks = 0; ks < 2; ++ks) { uf = __builtin_amdgcn_mfma_f32_16x16x32_bf16(gfrag(c.lds + M_KHF, 16 * dt, ks, fr, fq), bv[ks], uf, 0, 0, 0);
                                                  ub = __builtin_amdgcn_mfma_f32_16x16x32_bf16(gfrag(c.lds + M_KHB, 16 * dt, ks, fr, fq), bv[ks], ub, 0, 0, 0); }
                const f32x4 gf4 = *(const LAS f32x4*)(c.lds + M_GF + (16 * dt + 4 * fq) * 4), gb4 = *(const LAS f32x4*)(c.lds + M_GB + (16 * dt + 4 * fq) * 4);
                Tb[dt] = exp4(gb4) * Tb[dt] + ub; Tf[dt] = Tf[dt] + exp4(Lf[dt]) * uf; Lf[dt] = Lf[dt] + gf4; }
            GLA_BAR();
        }
#pragma unroll
        for (int dt = 0; dt < 4; ++dt) { const size_t o = ((size_t)u16 * 128 + 16 * w + fr) * 64 + 16 * dt + 4 * fq;
            *(f32x4*)(TT + o) = Tf[dt]; *(f32x4*)(TT + (size_t)256 * 8192 + o) = Tb[dt];
            if (w == 0 && fr == 0) *(f32x4*)(AFB + (size_t)u16 * 64 + 16 * dt + 4 * fq) = Lf[dt]; }
        if (c.tid < 64) AFB[(size_t)(256 + u16) * 64 + c.tid] = *((const LAS float*)(c.lds + M_LC) + c.tid);
    }
}
__device__ __forceinline__ bf16x8 gfrag_perm(const LAS unsigned char* base, int r0, int ks, int fr, int fq) {
    const LAS unsigned char* p = base + (r0 + fr) * GS + ks * 64 + fq * 8; const u32x2 lo = *(const LAS u32x2*)p, hi = *(const LAS u32x2*)(p + 32);
    return __builtin_bit_cast(bf16x8, (u32x4){lo.x, lo.y, hi.x, hi.y});
}
__device__ __forceinline__ void phase_gla_B2(const Ctx& c, const Args& a) {
    const bf16_t* Z = (const bf16_t*)(a.ws + WS_Z); const bf16_t* RS = (const bf16_t*)(a.ws + WS_RS); const float* TT = (const float*)(a.ws + WS_TT);
    const float* LCg = (const float*)(a.ws + WS_LC); const float* AFB = (const float*)(a.ws + WS_AFB); bf16_t* Y = (bf16_t*)(a.ws + WS_Y);
    const int fr = c.lane & 15, fq = c.lane >> 4, w = c.wave;
    const f32x4 gnv = *(const f32x4*)(a.in[I_GLAN] + 16 * w + 4 * fq);
    LAS float* red = (LAS float*)(c.lds + M_RED);
    int h_loaded = -1;
    for (int uu = blockIdx.x; uu < BATCH * GH * NSC; uu += c.G) {
        const int h = uu & 3, sc = (uu >> 2) & (NSC - 1), b = uu >> 6, bh = b * GH + h;
        __syncthreads();
        if (h != h_loaded) { gla_load_w2(c, a, h); h_loaded = h; }
        __syncthreads();
        PrepIn in; gla_prep_load(in, c, a, b, h, sc * SCN);
        f32x4 Sf[4], Sb[4];
#pragma unroll
        for (int dt = 0; dt < 4; ++dt) { Sf[dt] = (f32x4){0.f, 0.f, 0.f, 0.f}; Sb[dt] = Sf[dt]; }
        for (int s2 = 0; s2 < sc; ++s2) { const size_t u2 = (size_t)bh * NSC + s2;
#pragma unroll
            for (int dt = 0; dt < 4; ++dt) { const f32x4 af = *(const f32x4*)(AFB + u2 * 64 + 16 * dt + 4 * fq), tf = *(const f32x4*)(TT + (u2 * 128 + 16 * w + fr) * 64 + 16 * dt + 4 * fq);
                Sf[dt] = exp4(af) * Sf[dt] + tf; } }
        for (int s2 = NSC - 1; s2 > sc; --s2) { const size_t u2 = (size_t)bh * NSC + s2;
#pragma unroll
            for (int dt = 0; dt < 4; ++dt) { const f32x4 ab = *(const f32x4*)(AFB + (256 + u2) * 64 + 16 * dt + 4 * fq), tb = *(const f32x4*)(TT + (size_t)256 * 8192 + (u2 * 128 + 16 * w + fr) * 64 + 16 * dt + 4 * fq);
                Sb[dt] = exp4(ab) * Sb[dt] + tb; } }
        bf16x8 asb[2];
#pragma unroll
        for (int ks = 0; ks < 2; ++ks) asb[ks] = pack_frag(Sb[2 * ks], Sb[2 * ks + 1]);
        for (int n = 0; n < SCN; ++n) {
            const int chunk = sc * SCN + n; const size_t cg_ = (size_t)bh * NCH + chunk;
            const f32x4 lc0 = *(const f32x4*)(LCg + cg_ * 64 + 8 * w), lc1 = *(const f32x4*)(LCg + cg_ * 64 + 8 * w + 4);
            gla_prep2<false>(c, in, lc0, lc1);
            if (n + 1 < SCN) gla_prep_load(in, c, a, b, h, chunk + 1);
            bf16x8 rfr[2], asf[2]; u32x2 gr[4];
#pragma unroll
            for (int ks = 0; ks < 2; ++ks) { rfr[ks] = *(const bf16x8*)(RS + (cg_ * 128 + 16 * w + fr) * 64 + 32 * ks + 8 * fq); asf[ks] = pack_frag(Sf[2 * ks], Sf[2 * ks + 1]); }
#pragma unroll
            for (int tt = 0; tt < 4; ++tt) gr[tt] = *(const u32x2*)(Z + ((size_t)b * SEQ + chunk * 64 + 16 * tt + fr) * NZ + ZG + h * 128 + 16 * w + 4 * fq);
            GLA_BAR();
            { const int tt = w & 3;
#pragma unroll
              for (int s2 = 0; s2 < 2; ++s2) { const int ss = 2 * (w >> 2) + s2; f32x4 af = (f32x4){0.f, 0.f, 0.f, 0.f}, ab = af;
                  if (ss <= tt) {
#pragma unroll
                      for (int ks = 0; ks < 2; ++ks) af = __builtin_amdgcn_mfma_f32_16x16x32_bf16(gfrag(c.lds + M_KF, 16 * ss, ks, fr, fq), gfrag(c.lds + M_QF, 16 * tt, ks, fr, fq), af, 0, 0, 0); }
                  if (ss >= tt) {
#pragma unroll
                      for (int ks = 0; ks < 2; ++ks) ab = __builtin_amdgcn_mfma_f32_16x16x32_bf16(gfrag(c.lds + M_KB, 16 * ss, ks, fr, fq), gfrag(c.lds + M_QB, 16 * tt, ks, fr, fq), ab, 0, 0, 0); }
                  const int tpos = 16 * tt + fr, s0 = 16 * ss + 4 * fq; float v[4];
#pragma unroll
                  for (int i = 0; i < 4; ++i) v[i] = (s0 + i <= tpos) ? af[i] : ab[i];
                  u32x2 pk; pk.x = cvt_pk_bf16(v[0], v[1]); pk.y = cvt_pk_bf16(v[2], v[3]);
                  *(LAS u32x2*)(c.lds + M_AC + tpos * GS + s0 * 2) = pk; } }
            GLA_BAR();
            bf16x8 av[2];
#pragma unroll
            for (int ks = 0; ks < 2; ++ks) av[ks] = gfrag(c.lds + M_VT, 16 * w, ks, fr, fq);
            f32x4 o[4];
#pragma unroll
            for (int tt = 0; tt < 4; ++tt) { f32x4 acc = (f32x4){0.f, 0.f, 0.f, 0.f};
#pragma unroll
                for (int ks = 0; ks < 2; ++ks) { acc = __builtin_amdgcn_mfma_f32_16x16x32_bf16(av[ks], gfrag(c.lds + M_AC, 16 * tt, ks, fr, fq), acc, 0, 0, 0);
                    acc = __builtin_amdgcn_mfma_f32_16x16x32_bf16(asf[ks], gfrag_perm(c.lds + M_QF, 16 * tt, ks, fr, fq), acc, 0, 0, 0);
                    acc = __builtin_amdgcn_mfma_f32_16x16x32_bf16(rfr[ks], gfrag(c.lds + M_QB, 16 * tt, ks, fr, fq), acc, 0, 0, 0);
                    acc = __builtin_amdgcn_mfma_f32_16x16x32_bf16(asb[ks], gfrag_perm(c.lds + M_QB2, 16 * tt, ks, fr, fq), acc, 0, 0, 0); }
                o[tt] = acc;
                float p = (acc[0] * acc[0] + acc[1] * acc[1]) + (acc[2] * acc[2] + acc[3] * acc[3]);
                p += __shfl_xor(p, 16); p += __shfl_xor(p, 32);
                if (fq == 0) red[w * 64 + 16 * tt + fr] = p; }
#pragma unroll
            for (int dt = 0; dt < 4; ++dt) { f32x4 uf = (f32x4){0.f, 0.f, 0.f, 0.f};
#pragma unroll
                for (int ks = 0; ks < 2; ++ks) uf = __builtin_amdgcn_mfma_f32_16x16x32_bf16(gfrag(c.lds + M_KHF, 16 * dt, ks, fr, fq), av[ks], uf, 0, 0, 0);
                const f32x4 gf4 = *(const LAS f32x4*)(c.lds + M_GF + (16 * dt + 4 * fq) * 4);
                Sf[dt] = exp4(gf4) * Sf[dt] + uf; }
            GLA_BAR();
#pragma unroll
            for (int tt = 0; tt < 4; ++tt) { const int tpos = 16 * tt + fr; float s = 0.f;
#pragma unroll
                for (int ww = 0; ww < 8; ++ww) s += red[ww * 64 + tpos];
                const float rstd = rsqrtf(s * (1.0f / 128.0f) + EPS);
                const size_t row = (size_t)b * SEQ + chunk * 64 + tpos;
                const float g4[4] = {bf_lo(gr[tt].x), bf_hi(gr[tt].x), bf_lo(gr[tt].y), bf_hi(gr[tt].y)}; float y[4];
#pragma unroll
                for (int i = 0; i < 4; ++i) y[i] = o[tt][i] * rstd * gnv[i] * (g4[i] / (1.0f + __expf(-g4[i])));
                u32x2 pk; pk.x = cvt_pk_bf16(y[0], y[1]); pk.y = cvt_pk_bf16(y[2], y[3]);
                *(u32x2*)(Y + row * D + 512 + h * 128 + 16 * w + 4 * fq) = pk; }
            GLA_BAR();
        }
    }
}
__device__ __forceinline__ void phase_conv(const Ctx& c, const Args& a) {
    const bf16_t* Z = (const bf16_t*)(a.ws + WS_Z); bf16_t* Y = (bf16_t*)(a.ws + WS_Y);
    const float* cw = a.in[I_CONVW]; const float* cn = a.in[I_CONVN];
    const int c0 = 8 * c.lane;
    float w0[8], w1[8], w2[8], gn[8];
#pragma unroll
    for (int i = 0; i < 8; ++i) { w0[i] = cw[c0 + i]; w1[i] = cw[512 + c0 + i]; w2[i] = cw[1024 + c0 + i]; gn[i] = cn[c0 + i]; }
    for (int tok = c.gw; tok < T; tok += c.NGW) {
        const int s = tok % SEQ; const bf16_t* zr = Z + (size_t)tok * NZ + c0;
        const u32x4 cb = *(const u32x4*)(zr + ZCB), cc0 = *(const u32x4*)(zr + ZCC), cu0 = *(const u32x4*)(zr + ZCU);
        u32x4 ccm = (u32x4){0u, 0u, 0u, 0u}, cum = ccm, ccp = ccm, cup = ccm;
        if (s > 0) { ccm = *(const u32x4*)(zr - NZ + ZCC); cum = *(const u32x4*)(zr - NZ + ZCU); }
        if (s < SEQ - 1) { ccp = *(const u32x4*)(zr + NZ + ZCC); cup = *(const u32x4*)(zr + NZ + ZCU); }
        float y[8]; float ss = 0.f;
#pragma unroll
        for (int i = 0; i < 4; ++i) {
            const float hm0 = bf_lo(ccm[i]) * bf_lo(cum[i]), hm1 = bf_hi(ccm[i]) * bf_hi(cum[i]);
            const float h00 = bf_lo(cc0[i]) * bf_lo(cu0[i]), h01 = bf_hi(cc0[i]) * bf_hi(cu0[i]);
            const float hp0 = bf_lo(ccp[i]) * bf_lo(cup[i]), hp1 = bf_hi(ccp[i]) * bf_hi(cup[i]);
            y[2 * i] = bf_lo(cb[i]) * (w0[2 * i] * hm0 + w1[2 * i] * h00 + w2[2 * i] * hp0);
            y[2 * i + 1] = bf_hi(cb[i]) * (w0[2 * i + 1] * hm1 + w1[2 * i + 1] * h01 + w2[2 * i + 1] * hp1);
            ss += y[2 * i] * y[2 * i] + y[2 * i + 1] * y[2 * i + 1]; }
        ss += __shfl_xor(ss, 1); ss += __shfl_xor(ss, 2); ss += __shfl_xor(ss, 4);
        const float rstd = rsqrtf(ss * (1.0f / 64.0f) + EPS);
        u32x4 o;
#pragma unroll
        for (int i = 0; i < 4; ++i) o[i] = cvt_pk_bf16(y[2 * i] * rstd * gn[2 * i], y[2 * i + 1] * rstd * gn[2 * i + 1]);
        *(u32x4*)(Y + (size_t)tok * D + c0) = o;
    }
}
__device__ __forceinline__ void phase_scan(const Ctx& c, const Args& a) {
    const float* UU = (const float*)(a.ws + WS_UU); const float* GG = (const float*)(a.ws + WS_GG); bf16_t* SS = (bf16_t*)(a.ws + WS_SS);
    const int nthreads = c.G * 512;
    for (int idx = blockIdx.x * 512 + c.tid; idx < 2 * 16 * 8192; idx += nthreads) {
        const int dir = idx / (16 * 8192), rem = idx % (16 * 8192), bh = rem / 8192, ed = rem % 8192, d = ed & 63;
        const size_t ubase = (size_t)dir * NUNIT + (size_t)bh * NCH;
        float S = 0.f;
        for (int n0 = 0; n0 < NCH; n0 += 8) {
            float u[8], g[8];
#pragma unroll
            for (int j = 0; j < 8; ++j) { const int n = dir ? (NCH - 1 - (n0 + j)) : (n0 + j); u[j] = UU[(ubase + n) * 8192 + ed]; g[j] = GG[(ubase + n) * 64 + d]; }
#pragma unroll
            for (int j = 0; j < 8; ++j) { const int n = dir ? (NCH - 1 - (n0 + j)) : (n0 + j);
                SS[(ubase + n) * 8192 + ed] = (bf16_t)(cvt_pk_bf16(S, 0.f) & 0xffffu);
                S = __expf(g[j]) * S + u[j]; }
        }
    }
}
__device__ __forceinline__ void phase_gla_c(const Ctx& c, const Args& a) {
    const bf16_t* Z = (const bf16_t*)(a.ws + WS_Z); const bf16_t* SS = (const bf16_t*)(a.ws + WS_SS); bf16_t* Y = (bf16_t*)(a.ws + WS_Y);
    const int fr = c.lane & 15, fq = c.lane >> 4, w = c.wave;
    const f32x4 gnv = *(const f32x4*)(a.in[I_GLAN] + 16 * w + 4 * fq);
    LAS float* red = (LAS float*)(c.lds + L_RED);
    int h_loaded = -1;
    for (int uu = blockIdx.x; uu < NUNIT; uu += c.G) {
        const int h = uu & 3, n = (uu >> 2) & (NCH - 1), b = uu >> 9, unit = (b * GH + h) * NCH + n;
        __syncthreads();
        if (h != h_loaded) { gla_load_w(c, a, h); h_loaded = h; __syncthreads(); }
        gla_prep<false>(c, a, b, h, n, nullptr, nullptr);
        bf16x8 asf[2], asb[2];
#pragma unroll
        for (int ks = 0; ks < 2; ++ks) { asf[ks] = *(const bf16x8*)(SS + ((size_t)unit * 128 + 16 * w + fr) * 64 + 32 * ks + 8 * fq);
                                          asb[ks] = *(const bf16x8*)(SS + ((size_t)(NUNIT + unit) * 128 + 16 * w + fr) * 64 + 32 * ks + 8 * fq); }
        __syncthreads();
        { const int tt = w & 3;
#pragma unroll
          for (int s2 = 0; s2 < 2; ++s2) { const int ss = 2 * (w >> 2) + s2; f32x4 af = (f32x4){0.f, 0.f, 0.f, 0.f}, ab = af;
              if (ss <= tt) {
#pragma unroll
                  for (int ks = 0; ks < 2; ++ks) af = __builtin_amdgcn_mfma_f32_16x16x32_bf16(gfrag(c.lds + L_KF, 16 * ss, ks, fr, fq), gfrag(c.lds + L_QF, 16 * tt, ks, fr, fq), af, 0, 0, 0); }
              if (ss >= tt) {
#pragma unroll
                  for (int ks = 0; ks < 2; ++ks) ab = __builtin_amdgcn_mfma_f32_16x16x32_bf16(gfrag(c.lds + L_KB, 16 * ss, ks, fr, fq), gfrag(c.lds + L_QB, 16 * tt, ks, fr, fq), ab, 0, 0, 0); }
              const int tpos = 16 * tt + fr, s0 = 16 * ss + 4 * fq; float v[4];
#pragma unroll
              for (int i = 0; i < 4; ++i) v[i] = (s0 + i <= tpos) ? af[i] : ab[i];
              u32x2 pk; pk.x = cvt_pk_bf16(v[0], v[1]); pk.y = cvt_pk_bf16(v[2], v[3]);
              *(LAS u32x2*)(c.lds + L_AC + tpos * GS + s0 * 2) = pk; } }
        __syncthreads();
        bf16x8 av[2];
#pragma unroll
        for (int ks = 0; ks < 2; ++ks) av[ks] = gfrag(c.lds + L_VT, 16 * w, ks, fr, fq);
        f32x4 o[4];
#pragma unroll
        for (int tt = 0; tt < 4; ++tt) { f32x4 acc = (f32x4){0.f, 0.f, 0.f, 0.f};
#pragma unroll
            for (int ks = 0; ks < 2; ++ks) { acc = __builtin_amdgcn_mfma_f32_16x16x32_bf16(av[ks], gfrag(c.lds + L_AC, 16 * tt, ks, fr, fq), acc, 0, 0, 0);
                acc = __builtin_amdgcn_mfma_f32_16x16x32_bf16(asf[ks], gfrag(c.lds + L_QF, 16 * tt, ks, fr, fq), acc, 0, 0, 0);
                acc = __builtin_amdgcn_mfma_f32_16x16x32_bf16(asb[ks], gfrag(c.lds + L_QB, 16 * tt, ks, fr, fq), acc, 0, 0, 0); }
            o[tt] = acc;
            float p = (acc[0] * acc[0] + acc[1] * acc[1]) + (acc[2] * acc[2] + acc[3] * acc[3]);
            p += __shfl_xor(p, 16); p += __shfl_xor(p, 32);
            if (fq == 0) red[w * 64 + 16 * tt + fr] = p; }
        __syncthreads();
#pragma unroll
        for (int tt = 0; tt < 4; ++tt) { const int tpos = 16 * tt + fr; float s = 0.f;
#pragma unroll
            for (int ww = 0; ww < 8; ++ww) s += red[ww * 64 + tpos];
            const float rstd = rsqrtf(s * (1.0f / 128.0f) + EPS);
            const size_t row = (size_t)b * SEQ + n * 64 + tpos;
            const u32x2 gr = *(const u32x2*)(Z + row * NZ + ZG + h * 128 + 16 * w + 4 * fq);
            const float g4[4] = {bf_lo(gr.x), bf_hi(gr.x), bf_lo(gr.y), bf_hi(gr.y)}; float y[4];
#pragma unroll
            for (int i = 0; i < 4; ++i) y[i] = o[tt][i] * rstd * gnv[i] * (g4[i] / (1.0f + __expf(-g4[i])));
            u32x2 pk; pk.x = cvt_pk_bf16(y[0], y[1]); pk.y = cvt_pk_bf16(y[2], y[3]);
            *(u32x2*)(Y + row * D + 512 + h * 128 + 16 * w + 4 * fq) = pk; }
    }
}
__device__ __forceinline__ void phase_final(const Ctx& c, const Args& a) {
    const float* gain = a.in[I_FINN];
    for (int m = c.gw; m < T; m += c.NGW) {
        f32x4* xr = (f32x4*)(a.out + (size_t)m * D) + c.lane; const f32x4* gr = (const f32x4*)gain + c.lane;
        f32x4 v[4]; float s = 0.f;
#pragma unroll
        for (int j = 0; j < 4; ++j) { v[j] = xr[64 * j]; s += (v[j][0] * v[j][0] + v[j][1] * v[j][1]) + (v[j][2] * v[j][2] + v[j][3] * v[j][3]); }
        const float rstd = rsqrtf(wave_sum(s) * (1.f / D) + EPS);
#pragma unroll
        for (int j = 0; j < 4; ++j) xr[64 * j] = v[j] * rstd * gr[64 * j];
    }
}

__device__ __forceinline__ int lane_id_opaque() { int l; asm volatile("v_mbcnt_lo_u32_b32 %0, -1, 0\n\tv_mbcnt_hi_u32_b32 %0, -1, %0" : "=v"(l)); return l; }
typedef __attribute__((address_space(4))) const Args* KArgP;
__device__ __forceinline__ Args load_args() {
    Args a{};
#if defined(__HIP_DEVICE_COMPILE__)
    KArgP p = (KArgP)__builtin_amdgcn_kernarg_segment_ptr(); asm volatile("" : "+s"(p));
#pragma unroll
    for (int i = 0; i < 21; ++i) a.in[i] = p->in[i];
    a.out = p->out; a.ws = p->ws; a.ph_lo = p->ph_lo; a.ph_hi = p->ph_hi;
#endif
    return a;
}
#define XB_TMO      128
#define XB_XCNT(j)  (256  + 64 * (j))
#define XB_XSUB(j)  (1280 + 64 * (j))
#define XB_XGEN(j)  (2304 + 64 * (j))
#define XB_TOP      3328
#define XB_TOPGEN   3392
#define XCD_BAR_WORDS 3456
#define XB_SPIN_CAP (1u << 18)
__device__ __forceinline__ unsigned xb_ld(unsigned* p)              { return __hip_atomic_load(p, __ATOMIC_RELAXED, __HIP_MEMORY_SCOPE_AGENT); }
__device__ __forceinline__ unsigned xb_add(unsigned* p, unsigned v) { return __hip_atomic_fetch_add(p, v, __ATOMIC_RELAXED, __HIP_MEMORY_SCOPE_AGENT); }
__device__ __forceinline__ unsigned xb_xcc_id() { return (unsigned)__builtin_amdgcn_s_getreg((3 << 11) | 20) & 0xFu; }
#define XB_SPIN(cond, bar) do { unsigned _sp = 0; while (cond) { __builtin_amdgcn_s_sleep(1); \
    if ((++_sp & 255u) == 0u) { if (xb_ld(&(bar)[XB_TMO])) break; if (_sp > XB_SPIN_CAP) { atomicAdd(&(bar)[XB_TMO], 1u); break; } } } } while (0)
__device__ __forceinline__ void xcd_barrier_complete(unsigned* bar, unsigned x, unsigned& nloc, unsigned& nx) {
    const unsigned G = gridDim.x;
    unsigned sum, cnt, mine, sp = 0u;
    for (;;) {
        sum = 0u; cnt = 0u; mine = 0u;
#pragma unroll
        for (unsigned j = 0; j < 16; ++j) { const unsigned c = xb_ld(&bar[XB_XCNT(j)]); sum += c; cnt += (c > 0u) ? 1u : 0u; mine = (j == x) ? c : mine; }
        if (sum == G) break;
        __builtin_amdgcn_s_sleep(1);
        if ((++sp & 255u) == 0u) { if (xb_ld(&bar[XB_TMO])) break; if (sp > XB_SPIN_CAP) { atomicAdd(&bar[XB_TMO], 1u); break; } }
    }
    nloc = mine > 0u ? mine : 1u; nx = cnt > 0u ? cnt : 1u;
}
__device__ __forceinline__ void xcd_barrier(unsigned* bar, volatile LAS unsigned* st, bool first) {
    asm volatile("s_waitcnt vmcnt(0)" ::: "memory");
    __syncthreads();
    if (first) {
        const unsigned x = xb_xcc_id();
        __builtin_amdgcn_s_waitcnt(0);
        unsigned nloc = st[0], nx = st[1];
        if (nloc == 0u) { xcd_barrier_complete(bar, x, nloc, nx); st[0] = nloc; st[1] = nx; }
        const unsigned old = xb_add(&bar[XB_XSUB(x)], 1u);
        const unsigned gen = old / nloc;
        if (old + 1u == (gen + 1u) * nloc) {
            __builtin_amdgcn_fence(__ATOMIC_RELEASE, "agent");
            asm volatile("s_waitcnt vmcnt(0)" ::: "memory");
            const unsigned og = xb_add(&bar[XB_TOP], 1u);
            const unsigned tg = og / nx;
            if (og + 1u == (tg + 1u) * nx) xb_add(&bar[XB_TOPGEN], 1u);
            else XB_SPIN(xb_ld(&bar[XB_TOPGEN]) == tg, bar);
            __builtin_amdgcn_fence(__ATOMIC_ACQUIRE, "agent");
            xb_add(&bar[XB_XGEN(x)], 1u);
            asm volatile("s_waitcnt vmcnt(0)" ::: "memory");
        } else {
            XB_SPIN(xb_ld(&bar[XB_XGEN(x)]) == gen, bar);
            __builtin_amdgcn_fence(__ATOMIC_ACQUIRE, "agent");
            asm volatile("s_waitcnt vmcnt(0)" ::: "memory");
        }
    }
    __syncthreads();
}
constexpr int MISC_OFF = 139264;
__global__ void __launch_bounds__(512, 2) mk_fwd(Args args_unused) {
    extern __shared__ __attribute__((aligned(16))) unsigned char lds_raw[];
    const int wave0 = __builtin_amdgcn_readfirstlane(threadIdx.x >> 6);
#define MAKE_CTX() Ctx c; c.lds = (LAS unsigned char*)lds_raw; c.wave = wave0; c.lane = lane_id_opaque(); c.tid = c.wave * 64 + c.lane; c.G = gridDim.x; c.gw = blockIdx.x * 8 + c.wave; c.NGW = c.G * 8
    int lo, hi; { const Args a0 = load_args(); lo = a0.ph_lo; hi = a0.ph_hi; }
#if MK_MODE == 1
#define GRID_BAR(k) cg::this_grid().sync()
#elif MK_MODE == 2
    unsigned* const xbar = (unsigned*)(load_args().ws + WS_CTL);
    volatile LAS unsigned* const xst = (volatile LAS unsigned*)((LAS unsigned char*)lds_raw + MISC_OFF);
    { const int l0 = lane_id_opaque(); if (wave0 == 0 && l0 < 4) xst[l0] = 0u; __syncthreads();
      if (wave0 == 0 && l0 == 0) (void)xb_add(&xbar[XB_XCNT(xb_xcc_id())], 1u); }
#if MK_CG_FIRST
#define GRID_BAR(k) do { if ((k) == 0) cg::this_grid().sync(); else xcd_barrier(xbar, xst, wave0 == 0 && lane_id_opaque() == 0); } while (0)
#else
#define GRID_BAR(k) xcd_barrier(xbar, xst, wave0 == 0 && lane_id_opaque() == 0)
#endif
#else
#define GRID_BAR(k) do { } while (0)
#endif
#ifndef PHASE_MASK
#define PHASE_MASK 0x1fff
#endif
#define IN(k) (((PHASE_MASK >> (k)) & 1) && lo <= (k) && (k) < hi)
#ifndef REP_MASK
#define REP_MASK 0x0
#endif
#define SEAM(k) do { if (IN(k) && IN((k) + 1)) { GRID_BAR(k); } } while (0)
    using namespace pg8;

    if (IN(0)) for (int rep_ = 0; rep_ <= ((REP_MASK >> 0) & 1); ++rep_) { MAKE_CTX(); const Args args = load_args(); phase_prologue(c, args); SEAM(0); }
    if (IN(1)) for (int rep_ = 0; rep_ <= ((REP_MASK >> 1) & 1); ++rep_) { MAKE_CTX(); const Args args = load_args(); unsigned char* ws = args.ws; bf16_t* XN = (bf16_t*)(ws + WS_XN);
        { ProbPlain g{XN, (const bf16_t*)(ws + WS_WIN), D, D, D}; StaticOrder S; S.init(T, NZP, c.G, (int)blockIdx.x);
          EpiZ E{(bf16_t*)(ws + WS_Z), (float*)(ws + WS_LR)};
          gemm_phase<EpiZ, ProbPlain, StaticOrder, true>(c.lds, c.tid, c.wave, g, S, E); }
        __syncthreads();
        { ProbPlain g{(const bf16_t*)(ws + WS_MN), (const bf16_t*)(ws + WS_WXKV), D, D, D}; StaticOrder S; S.init(MROWS, 2 * D, c.G, (int)blockIdx.x);
          EpiKV E{(bf16_t*)(ws + WS_KMEM), (bf16_t*)(ws + WS_VT)};
          gemm_phase<EpiKV, ProbPlain, StaticOrder, true>(c.lds, c.tid, c.wave, g, S, E); }
        SEAM(1);
    }
    if (IN(2)) for (int rep_ = 0; rep_ <= ((REP_MASK >> 2) & 1); ++rep_) { MAKE_CTX(); const Args args = load_args();
#ifndef NO_GLA_A
        phase_gla_A2(c, args);
#endif
#ifndef NO_CONV
        phase_conv(c, args);
#endif
        SEAM(2); }
    if (IN(3)) for (int rep_ = 0; rep_ <= ((REP_MASK >> 3) & 1); ++rep_) { MAKE_CTX(); const Args args = load_args(); phase_gla_B2(c, args); SEAM(3); }
    if (IN(5)) for (int rep_ = 0; rep_ <= ((REP_MASK >> 5) & 1); ++rep_) { MAKE_CTX(); const Args args = load_args(); unsigned char* ws = args.ws; bf16_t* XN = (bf16_t*)(ws + WS_XN); float* SSQ = (float*)(ws + WS_SSQ); (void)XN; (void)SSQ;
        ProbPlain g{(const bf16_t*)(ws + WS_Y), (const bf16_t*)(ws + WS_WOUT), D, D, D}; StaticOrder S; S.init(T, D, c.G, (int)blockIdx.x);
        EpiRes<true> E{args.in[I_X], args.out, args.in[I_XAN], XN, SSQ};
        gemm_phase<EpiRes<true>, ProbPlain, StaticOrder, true>(c.lds, c.tid, c.wave, g, S, E);
        SEAM(5);
    }
    if (IN(6)) for (int rep_ = 0; rep_ <= ((REP_MASK >> 6) & 1); ++rep_) { MAKE_CTX(); const Args args = load_args(); unsigned char* ws = args.ws; bf16_t* XN = (bf16_t*)(ws + WS_XN); float* SSQ = (float*)(ws + WS_SSQ); (void)XN; (void)SSQ;
        ProbPlain g{XN, (const bf16_t*)(ws + WS_WXQ), D, D, D}; StaticOrder S; S.init(T, D, c.G, (int)blockIdx.x);
        EpiScale<0> E{(bf16_t*)(ws + WS_HQ), D, SSQ, 1.0f / 16.0f};
        gemm_phase<EpiScale<0>, ProbPlain, StaticOrder, true>(c.lds, c.tid, c.wave, g, S, E);
        SEAM(6);
    }
    if (IN(7)) for (int rep_ = 0; rep_ <= ((REP_MASK >> 7) & 1); ++rep_) { MAKE_CTX(); const Args args = load_args(); unsigned char* ws = args.ws; bf16_t* XN = (bf16_t*)(ws + WS_XN); float* SSQ = (float*)(ws + WS_SSQ); (void)XN; (void)SSQ;
        ProbQK g{(const bf16_t*)(ws + WS_HQ), (const bf16_t*)(ws + WS_KMEM), D, D, 256}; StaticOrder S; S.init(T, D, c.G, (int)blockIdx.x);
        EpiSoftmax E{(bf16_t*)(ws + WS_P), D, (LAS float*)(c.lds + EPI_LDS_OFF)};
        gemm_phase<EpiSoftmax, ProbQK, StaticOrder, true>(c.lds, c.tid, c.wave, g, S, E);
        SEAM(7);
    }
    if (IN(8)) for (int rep_ = 0; rep_ <= ((REP_MASK >> 8) & 1); ++rep_) { MAKE_CTX(); const Args args = load_args(); unsigned char* ws = args.ws; bf16_t* XN = (bf16_t*)(ws + WS_XN); float* SSQ = (float*)(ws + WS_SSQ); (void)XN; (void)SSQ;
        ProbPV g{(const bf16_t*)(ws + WS_P), (const bf16_t*)(ws + WS_VT), D, 256, 256}; StaticOrder S; S.init(T, D, c.G, (int)blockIdx.x);
        EpiBf16 E{(bf16_t*)(ws + WS_O), D};
        gemm_phase<EpiBf16, ProbPV, StaticOrder, true>(c.lds, c.tid, c.wave, g, S, E);
        SEAM(8);
    }
    if (IN(9)) for (int rep_ = 0; rep_ <= ((REP_MASK >> 9) & 1); ++rep_) { MAKE_CTX(); const Args args = load_args(); unsigned char* ws = args.ws; bf16_t* XN = (bf16_t*)(ws + WS_XN); float* SSQ = (float*)(ws + WS_SSQ); (void)XN; (void)SSQ;
        ProbPlain g{(const bf16_t*)(ws + WS_O), (const bf16_t*)(ws + WS_WXO), D, D, D}; StaticOrder S; S.init(T, D, c.G, (int)blockIdx.x);
        EpiRes<true> E{args.out, (float*)(ws + WS_RB), args.in[I_MLPN], XN, SSQ};
        gemm_phase<EpiRes<true>, ProbPlain, StaticOrder, true>(c.lds, c.tid, c.wave, g, S, E);
        SEAM(9);
    }
    if (IN(10)) for (int rep_ = 0; rep_ <= ((REP_MASK >> 10) & 1); ++rep_) { MAKE_CTX(); const Args args = load_args(); unsigned char* ws = args.ws; bf16_t* XN = (bf16_t*)(ws + WS_XN); float* SSQ = (float*)(ws + WS_SSQ); (void)XN; (void)SSQ;
        ProbPlain g{XN, (const bf16_t*)(ws + WS_WUP), D, D, D}; StaticOrder S; S.init(T, FF, c.G, (int)blockIdx.x);
        EpiScale<1> E{(bf16_t*)(ws + WS_U), FF, SSQ, 1.0f};
        gemm_phase<EpiScale<1>, ProbPlain, StaticOrder, true>(c.lds, c.tid, c.wave, g, S, E);
        SEAM(10);
    }
    if (IN(11)) for (int rep_ = 0; rep_ <= ((REP_MASK >> 11) & 1); ++rep_) { MAKE_CTX(); const Args args = load_args(); unsigned char* ws = args.ws; bf16_t* XN = (bf16_t*)(ws + WS_XN); float* SSQ = (float*)(ws + WS_SSQ); (void)XN; (void)SSQ;
        ProbPlain g{(const bf16_t*)(ws + WS_U), (const bf16_t*)(ws + WS_WDN), FF, FF, FF}; StaticOrder S; S.init(T, D, c.G, (int)blockIdx.x);
        EpiRes<false> E{(const float*)(ws + WS_RB), args.out, nullptr, nullptr, nullptr};
        gemm_phase<EpiRes<false>, ProbPlain, StaticOrder, true>(c.lds, c.tid, c.wave, g, S, E);
        SEAM(11);
    }
    if (IN(12)) for (int rep_ = 0; rep_ <= ((REP_MASK >> 12) & 1); ++rep_) { MAKE_CTX(); const Args args = load_args(); phase_final(c, args); }
#undef IN
#undef SEAM
#undef GRID_BAR
}

extern "C" void kernel_launch(void* const* d_in, const int* in_sizes, int n_in, void* d_out, int out_size, void* d_ws, size_t ws_size, hipStream_t stream) {
    static int grid = 0;
    if (grid == 0) {
        if (n_in != 21 || in_sizes[0] != T * D || out_size != T * D || ws_size < WS_END) {
            fprintf(stderr, "kernel_launch: unexpected shapes: n_in %d in0 %d out %d ws %zu (need %zu); nothing launched\n", n_in, n_in > 0 ? in_sizes[0] : -1, out_size, ws_size, (size_t)WS_END); grid = -1; return; }
        int dev = 0, cus = 0, per_cu = 0;
        if (hipGetDevice(&dev) != hipSuccess || hipDeviceGetAttribute(&cus, hipDeviceAttributeMultiprocessorCount, dev) != hipSuccess) { fprintf(stderr, "kernel_launch: device query failed\n"); grid = -1; return; }
        if (hipFuncSetAttribute((const void*)mk_fwd, hipFuncAttributeMaxDynamicSharedMemorySize, LDS_BYTES) != hipSuccess) { fprintf(stderr, "kernel_launch: hipFuncSetAttribute failed\n"); grid = -1; return; }
        if (hipOccupancyMaxActiveBlocksPerMultiprocessor(&per_cu, (const void*)mk_fwd, 512, LDS_BYTES) != hipSuccess || per_cu < 1) { fprintf(stderr, "kernel_launch: occupancy query says %d blocks per CU\n", per_cu); (void)hipGetLastError(); grid = -1; return; }
        grid = cus * (per_cu < 1 ? 1 : 1);
        fprintf(stderr, "kernel_launch: %d CUs, occupancy query %d per CU, grid %d\n", cus, per_cu, grid);
    }
    if (grid < 0) return;
    Args a{};
    for (int i = 0; i < 21; ++i) a.in[i] = (const float*)d_in[i];
    a.out = (float*)d_out; a.ws = (unsigned char*)d_ws;
#if MK_MODE == 0
    for (int p = 0; p < N_PHASES; ++p) { a.ph_lo = p; a.ph_hi = p + 1; hipLaunchKernelGGL(mk_fwd, dim3(grid), dim3(512), LDS_BYTES, stream, a); }
#else
    a.ph_lo = 0; a.ph_hi = N_PHASES;
#if MK_MODE == 2
    if (hipMemsetAsync((char*)d_ws + WS_CTL, 0, 65536, stream) != hipSuccess) { fprintf(stderr, "kernel_launch: memset of the barrier words failed\n"); return; }
#endif
#if MK_MODE == 2 && !MK_CG_FIRST
    hipLaunchKernelGGL(mk_fwd, dim3(grid), dim3(512), LDS_BYTES, stream, a);
#else
    void* kargs[] = {&a};
    hipError_t e = hipLaunchCooperativeKernel((const void*)mk_fwd, dim3(grid), dim3(512), kargs, LDS_BYTES, stream);
    if (e != hipSuccess) fprintf(stderr, "kernel_launch: cooperative launch failed: %s (grid %d)\n", hipGetErrorString(e), grid);
#endif
#endif
}
```

```cpp
#include <hip/hip_runtime.h>
#include <hip/hip_cooperative_groups.h>
#include <cstdio>
#include <cstdint>
namespace cg = cooperative_groups;

#ifndef MK_MODE
#define MK_MODE 2
#endif
#ifndef MK_CG_FIRST
#define MK_CG_FIRST 0
#endif

#define LAS __attribute__((address_space(3)))
typedef unsigned short bf16_t;
typedef short bf16x8 __attribute__((ext_vector_type(8)));
typedef float f32x4 __attribute__((ext_vector_type(4)));
typedef float f32x2 __attribute__((ext_vector_type(2)));
typedef unsigned u32x4 __attribute__((ext_vector_type(4)));
typedef unsigned u32x2 __attribute__((ext_vector_type(2)));

constexpr int BATCH = 4, SEQ = 8192, T = BATCH * SEQ, D = 1024, NMEM = 256, MROWS = BATCH * NMEM;
constexpr int WIN = 3104, NZ = 3072, NZP = 3328, FF = 4096;
constexpr int ZCB = 0, ZCC = 512, ZCU = 1024, ZQ = 1536, ZK = 1792, ZV = 2048, ZG = 2560;
constexpr int GH = 4, NCH = SEQ / 64, NUNIT = BATCH * GH * NCH;
constexpr float EPS = 1e-6f;

constexpr size_t MiB = 1u << 20;
constexpr size_t WS_CTL = 0;
constexpr size_t WS_WIN = 1 * MiB;
constexpr size_t WS_WOUT = 8 * MiB;
constexpr size_t WS_WXQ = 10 * MiB;
constexpr size_t WS_WXKV = 12 * MiB;
constexpr size_t WS_WXO = 16 * MiB;
constexpr size_t WS_WUP = 18 * MiB;
constexpr size_t WS_WDN = 26 * MiB;
constexpr size_t WS_MN = 34 * MiB;
constexpr size_t WS_KMEM = 36 * MiB;
constexpr size_t WS_VT = 38 * MiB;
constexpr size_t WS_SSQ = 40 * MiB;
constexpr size_t WS_LR = 42 * MiB;
constexpr size_t WS_GG = 46 * MiB;
constexpr size_t WS_XN = 48 * MiB;
constexpr size_t WS_SS = 48 * MiB;
constexpr size_t WS_Y = 112 * MiB;
constexpr size_t WS_HQ = 112 * MiB;
constexpr size_t WS_Z = 176 * MiB;
constexpr size_t WS_P = 176 * MiB;
constexpr size_t WS_O = 240 * MiB;
constexpr size_t WS_UU = 368 * MiB;
constexpr size_t WS_XB2 = 368 * MiB;
constexpr size_t WS_RSTD0 = 47 * MiB;
constexpr size_t WS_U = 112 * MiB;
constexpr size_t WS_END = 496 * MiB;

constexpr int LDS_BYTES = 147456;
constexpr int RING_BYTES = 131072;
constexpr int EPI_LDS_OFF = RING_BYTES;

__device__ __forceinline__ unsigned cvt_pk_bf16(float lo, float hi) { unsigned r; asm volatile("v_cvt_pk_bf16_f32 %0, %1, %2" : "=v"(r) : "v"(lo), "v"(hi)); return r; }
__device__ __forceinline__ float bf_lo(unsigned x) { return __uint_as_float(x << 16); }
__device__ __forceinline__ float bf_hi(unsigned x) { return __uint_as_float(x & 0xffff0000u); }
__device__ __forceinline__ float wave_sum(float v) {
#pragma unroll
    for (int o = 1; o < 64; o <<= 1) v += __shfl_xor(v, o);
    return v;
}
#define LDS_WAIT() asm volatile("s_waitcnt lgkmcnt(0)" ::: "memory")
#define VM_WAIT() asm volatile("s_waitcnt vmcnt(0)" ::: "memory")

namespace pg8 {
constexpr int BM = 256, BK = 64, HALF = 128, HTB = HALF * BK * 2, STAGE_BYTES = 8 * HTB, NXCD = 8, WGM = 8;
__host__ __device__ __forceinline__ int lds_byte(int r, int c) { const int st = (r >> 4) * 2 + (c >> 5), rr = r & 15, cc = c & 31, ob = rr * 64 + cc * 2; return st * 1024 + (ob ^ (((ob >> 9) & 1) << 5)); }
__host__ __device__ __forceinline__ void stage_rc(int b, int& R, int& C) { const int st = b / 1024, sb = b % 1024, swz = sb ^ (((sb >> 9) & 1) << 5); R = (st >> 1) * 16 + swz / 64; C = (st & 1) * 32 + (swz % 64) / 2; }
__host__ __device__ __forceinline__ int perm32(int rho) { const int n = rho >> 4, i = rho & 15; return 8 * (i >> 2) + 4 * n + (i & 3); }

struct Unit { int pm, pn; };

struct StaticOrder {
    int nM, nN, nwg, G, c;
    __host__ __device__ void init(int M, int N, int G_, int c_) { nM = M / BM; nN = N / BM; nwg = nM * nN; G = G_; c = c_; }
    __host__ __device__ bool next(int i, Unit& u) const {
        const long L = (long)i * G + c; if (L >= nwg) return false;
        int wgid = (int)L; { const int q = nwg / NXCD, r = nwg % NXCD, xcd = wgid % NXCD, off = wgid / NXCD; wgid = (xcd < r ? xcd * (q + 1) : r * (q + 1) + (xcd - r) * q) + off; }
        const int nig = WGM * nN, gid = wgid / nig, fm = gid * WGM, gsz = (nM - fm) < WGM ? (nM - fm) : WGM;
        u.pm = fm + ((wgid % nig) % gsz); u.pn = (wgid % nig) / gsz; return true;
    }
};

struct ProbPlain { const bf16_t* A; const bf16_t* Bt; int lda, ldb, K;
    __device__ __forceinline__ const char* a_base(const Unit& u) const { return (const char*)(A + (size_t)u.pm * BM * lda); }
    __device__ __forceinline__ const char* b_base(const Unit& u) const { return (const char*)(Bt + (size_t)u.pn * BM * ldb); } };
struct ProbQK { const bf16_t* A; const bf16_t* Bt; int lda, ldb, K;
    __device__ __forceinline__ const char* a_base(const Unit& u) const { return (const char*)(A + (size_t)u.pm * BM * lda + u.pn * 256); }
    __device__ __forceinline__ const char* b_base(const Unit& u) const { return (const char*)(Bt + (size_t)(u.pm >> 5) * 256 * ldb + u.pn * 256); } };
struct ProbPV { const bf16_t* A; const bf16_t* Bt; int lda, ldb, K;
    __device__ __forceinline__ const char* a_base(const Unit& u) const { return (const char*)(A + (size_t)u.pm * BM * lda + u.pn * 256); }
    __device__ __forceinline__ const char* b_base(const Unit& u) const { return (const char*)(Bt + (size_t)((u.pm >> 5) * 4 + u.pn) * 256 * ldb); } };

typedef f32x4 Acc[2][2][4][2];

__device__ __forceinline__ void store8_bf16(bf16_t* p, f32x4 v0, f32x4 v1) {
    u32x4 w; w.x = cvt_pk_bf16(v0[0], v0[1]); w.y = cvt_pk_bf16(v0[2], v0[3]); w.z = cvt_pk_bf16(v1[0], v1[1]); w.w = cvt_pk_bf16(v1[2], v1[3]);
    *(u32x4*)p = w;
}

struct EpiBf16 { static constexpr bool PERM = true; bf16_t* O; int ldc;
    __device__ __forceinline__ void operator()(Acc& acc, const Unit& u, int wr, int wc, int fr, int fq) const {
        const int row0 = u.pm * BM + wr * 64 + fr, col0 = u.pn * BM + wc * 32 + 8 * fq;
#pragma unroll
        for (int ai = 0; ai < 2; ++ai)
#pragma unroll
            for (int m = 0; m < 4; ++m) { bf16_t* rowp = O + (size_t)(row0 + ai * HALF + m * 16) * ldc + col0;
#pragma unroll
                for (int bj = 0; bj < 2; ++bj) store8_bf16(rowp + bj * HALF, acc[ai][bj][m][0], acc[ai][bj][m][1]); }
    }
};
struct EpiZ { static constexpr bool PERM = true; bf16_t* Z; float* LR; const float* RSTD;
    __device__ __forceinline__ void operator()(Acc& acc, const Unit& u, int wr, int wc, int fr, int fq) const {
        const int row0 = u.pm * BM + wr * 64 + fr;
        if (u.pn < 12) {
            const int col0 = u.pn * BM + wc * 32 + 8 * fq;
#pragma unroll
            for (int ai = 0; ai < 2; ++ai)
#pragma unroll
                for (int m = 0; m < 4; ++m) { const int row = row0 + ai * HALF + m * 16; const float rs = RSTD[row]; bf16_t* rowp = Z + (size_t)row * NZ + col0;
#pragma unroll
                    for (int bj = 0; bj < 2; ++bj) store8_bf16(rowp + bj * HALF, acc[ai][bj][m][0] * rs, acc[ai][bj][m][1] * rs); }
        } else if (wc == 0) {
#pragma unroll
            for (int ai = 0; ai < 2; ++ai)
#pragma unroll
                for (int m = 0; m < 4; ++m) { const int row = row0 + ai * HALF + m * 16; const float rs = RSTD[row]; float* p = LR + (size_t)row * 32 + 8 * fq;
                    *(f32x4*)p = acc[ai][0][m][0] * rs; *(f32x4*)(p + 4) = acc[ai][0][m][1] * rs; }
        }
    }
};
struct EpiKV { static constexpr bool PERM = true; bf16_t* Kmem; bf16_t* Vt;
    __device__ __forceinline__ void operator()(Acc& acc, const Unit& u, int wr, int wc, int fr, int fq) const {
        if (u.pn < 4) {
            const int row0 = u.pm * BM + wr * 64 + fr, col0 = u.pn * BM + wc * 32 + 8 * fq;
#pragma unroll
            for (int ai = 0; ai < 2; ++ai)
#pragma unroll
                for (int m = 0; m < 4; ++m) { bf16_t* rowp = Kmem + (size_t)(row0 + ai * HALF + m * 16) * 1024 + col0;
#pragma unroll
                    for (int bj = 0; bj < 2; ++bj) store8_bf16(rowp + bj * HALF, acc[ai][bj][m][0], acc[ai][bj][m][1]); }
        } else {
            bf16_t* vb = Vt + (size_t)(u.pm * 4 + (u.pn - 4)) * 256 * 256;
#pragma unroll
            for (int ai = 0; ai < 2; ++ai)
#pragma unroll
                for (int m = 0; m < 4; ++m) { const int key = ai * HALF + wr * 64 + m * 16 + fr;
#pragma unroll
                    for (int bj = 0; bj < 2; ++bj) { const int dim0 = bj * HALF + wc * 32 + 8 * fq;
#pragma unroll
                        for (int n = 0; n < 2; ++n) { const f32x4 v = acc[ai][bj][m][n]; const unsigned a = cvt_pk_bf16(v[0], v[1]), b = cvt_pk_bf16(v[2], v[3]);
                            bf16_t* q = vb + (size_t)(dim0 + 4 * n) * 256 + key;
                            q[0] = (bf16_t)(a & 0xffffu); q[256] = (bf16_t)(a >> 16); q[512] = (bf16_t)(b & 0xffffu); q[768] = (bf16_t)(b >> 16); } } }
        }
    }
};
template <bool NORM> struct EpiRes { static constexpr bool PERM = false; const float* base; float* out; const float* gain; bf16_t* XN; float* SSQ;
    __device__ __forceinline__ void operator()(Acc& acc, const Unit& u, int wr, int wc, int fr, int fq) const {
        const int row0 = u.pm * BM + wr * 64 + fr, col0 = u.pn * BM + wc * 32 + 4 * fq;
        f32x4 gv[2][2];
        if (NORM) {
#pragma unroll
            for (int bj = 0; bj < 2; ++bj)
#pragma unroll
                for (int n = 0; n < 2; ++n) gv[bj][n] = *(const f32x4*)(gain + col0 + bj * HALF + n * 16);
        }
#pragma unroll
        for (int ai = 0; ai < 2; ++ai)
#pragma unroll
            for (int m = 0; m < 4; ++m) { const int row = row0 + ai * HALF + m * 16; const size_t off = (size_t)row * D + col0; float ss = 0.f;
#pragma unroll
                for (int bj = 0; bj < 2; ++bj)
#pragma unroll
                    for (int n = 0; n < 2; ++n) { const f32x4 v = *(const f32x4*)(base + off + bj * HALF + n * 16) + acc[ai][bj][m][n];
                        *(f32x4*)(out + off + bj * HALF + n * 16) = v;
                        if (NORM) { ss += (v[0] * v[0] + v[1] * v[1]) + (v[2] * v[2] + v[3] * v[3]); const f32x4 w = v * gv[bj][n];
                            u32x2 pk; pk.x = cvt_pk_bf16(w[0], w[1]); pk.y = cvt_pk_bf16(w[2], w[3]); *(u32x2*)(XN + off + bj * HALF + n * 16) = pk; } }
                if (NORM) { ss += __shfl_xor(ss, 16); ss += __shfl_xor(ss, 32); if (fq == 0) SSQ[(size_t)row * 16 + u.pn * 4 + wc] = ss; }
                if (m & 1) asm volatile("" ::: "memory"); }
    }
};
template <bool BASE_F32> struct EpiResB { static constexpr bool PERM = true; const void* base; bf16_t* out; float* SSQ;
    __device__ __forceinline__ void operator()(Acc& acc, const Unit& u, int wr, int wc, int fr, int fq) const {
        const int row0 = u.pm * BM + wr * 64 + fr, col0 = u.pn * BM + wc * 32 + 8 * fq;
#pragma unroll
        for (int ai = 0; ai < 2; ++ai)
#pragma unroll
            for (int m = 0; m < 4; ++m) { const int row = row0 + ai * HALF + m * 16; const size_t off = (size_t)row * D + col0; float ss = 0.f;
#pragma unroll
                for (int bj = 0; bj < 2; ++bj) { f32x4 b0, b1;
                    if (BASE_F32) { const float* bp = (const float*)base + off + bj * HALF; b0 = *(const f32x4*)bp; b1 = *(const f32x4*)(bp + 4); }
                    else { const u32x4 r = *(const u32x4*)((const bf16_t*)base + off + bj * HALF); b0 = (f32x4){bf_lo(r.x), bf_hi(r.x), bf_lo(r.y), bf_hi(r.y)}; b1 = (f32x4){bf_lo(r.z), bf_hi(r.z), bf_lo(r.w), bf_hi(r.w)}; }
                    const f32x4 v0 = b0 + acc[ai][bj][m][0], v1 = b1 + acc[ai][bj][m][1];
                    ss += ((v0[0] * v0[0] + v0[1] * v0[1]) + (v0[2] * v0[2] + v0[3] * v0[3])) + ((v1[0] * v1[0] + v1[1] * v1[1]) + (v1[2] * v1[2] + v1[3] * v1[3]));
                    store8_bf16(out + off + bj * HALF, v0, v1); }
                ss += __shfl_xor(ss, 16); ss += __shfl_xor(ss, 32); if (fq == 0) SSQ[(size_t)row * 16 + u.pn * 4 + wc] = ss;
                if (m & 1) asm volatile("" ::: "memory"); }
    }
};
struct EpiResF { static constexpr bool PERM = false; const bf16_t* base; float* out;
    __device__ __forceinline__ void operator()(Acc& acc, const Unit& u, int wr, int wc, int fr, int fq) const {
        const int row0 = u.pm * BM + wr * 64 + fr, col0 = u.pn * BM + wc * 32 + 4 * fq;
#pragma unroll
        for (int ai = 0; ai < 2; ++ai)
#pragma unroll
            for (int m = 0; m < 4; ++m) { const size_t off = (size_t)(row0 + ai * HALF + m * 16) * D + col0;
#pragma unroll
                for (int bj = 0; bj < 2; ++bj)
#pragma unroll
                    for (int n = 0; n < 2; ++n) { const u32x2 r = *(const u32x2*)(base + off + bj * HALF + n * 16);
                        *(f32x4*)(out + off + bj * HALF + n * 16) = (f32x4){bf_lo(r.x), bf_hi(r.x), bf_lo(r.y), bf_hi(r.y)} + acc[ai][bj][m][n]; }
                if (m & 1) asm volatile("" ::: "memory"); }
    }
};
template <int ACT> struct EpiScale { static constexpr bool PERM = true; bf16_t* O; int ldc; const float* SSQ; float post;
    __device__ __forceinline__ void operator()(Acc& acc, const Unit& u, int wr, int wc, int fr, int fq) const {
        const int row0 = u.pm * BM + wr * 64 + fr, col0 = u.pn * BM + wc * 32 + 8 * fq;
#pragma unroll
        for (int ai = 0; ai < 2; ++ai)
#pragma unroll
            for (int m = 0; m < 4; ++m) { const int row = row0 + ai * HALF + m * 16; const f32x4* sp = (const f32x4*)(SSQ + (size_t)row * 16);
                const f32x4 s4 = (sp[0] + sp[1]) + (sp[2] + sp[3]); const float s = (s4[0] + s4[1]) + (s4[2] + s4[3]);
                const float rs = rsqrtf(s * (1.0f / D) + EPS) * post; bf16_t* rowp = O + (size_t)row * ldc + col0;
#pragma unroll
                for (int bj = 0; bj < 2; ++bj) { f32x4 v0 = acc[ai][bj][m][0] * rs, v1 = acc[ai][bj][m][1] * rs;
                    if (ACT == 1) {
#pragma unroll
                        for (int i = 0; i < 4; ++i) { const float a = fmaxf(v0[i], 0.f), b = fmaxf(v1[i], 0.f); v0[i] = a * a; v1[i] = b * b; } }
                    store8_bf16(rowp + bj * HALF, v0, v1); } }
    }
};
struct EpiSoftmax { static constexpr bool PERM = true; bf16_t* P; int ldc; LAS float* red;
    __device__ __forceinline__ void operator()(Acc& acc, const Unit& u, int wr, int wc, int fr, int fq) const {
        LAS float* red0 = red; LAS float* red1 = red + 1024;
#pragma unroll
        for (int ai = 0; ai < 2; ++ai)
#pragma unroll
            for (int m = 0; m < 4; ++m) { float mx = -3.0e38f;
#pragma unroll
                for (int bj = 0; bj < 2; ++bj)
#pragma unroll
                    for (int n = 0; n < 2; ++n) { const f32x4 v = acc[ai][bj][m][n]; mx = fmaxf(mx, fmaxf(fmaxf(v[0], v[1]), fmaxf(v[2], v[3]))); }
                mx = fmaxf(mx, __shfl_xor(mx, 16)); mx = fmaxf(mx, __shfl_xor(mx, 32));
                if (fq == 0) red0[(ai * HALF + wr * 64 + m * 16 + fr) * 4 + wc] = mx; }
        LDS_WAIT(); __builtin_amdgcn_s_barrier(); asm volatile("" ::: "memory");
#pragma unroll
        for (int ai = 0; ai < 2; ++ai)
#pragma unroll
            for (int m = 0; m < 4; ++m) { const int r = ai * HALF + wr * 64 + m * 16 + fr; const f32x4 q = *(const LAS f32x4*)(red0 + r * 4);
                const float M = fmaxf(fmaxf(q[0], q[1]), fmaxf(q[2], q[3])); float s = 0.f;
#pragma unroll
                for (int bj = 0; bj < 2; ++bj)
#pragma unroll
                    for (int n = 0; n < 2; ++n) { f32x4 v = acc[ai][bj][m][n];
#pragma unroll
                        for (int i = 0; i < 4; ++i) { v[i] = __expf(v[i] - M); s += v[i]; }
                        acc[ai][bj][m][n] = v; }
                s += __shfl_xor(s, 16); s += __shfl_xor(s, 32);
                if (fq == 0) red1[r * 4 + wc] = s; }
        LDS_WAIT(); __builtin_amdgcn_s_barrier(); asm volatile("" ::: "memory");
        const int row0 = u.pm * BM + wr * 64 + fr, col0 = u.pn * BM + wc * 32 + 8 * fq;
#pragma unroll
        for (int ai = 0; ai < 2; ++ai)
#pragma unroll
            for (int m = 0; m < 4; ++m) { const int r = ai * HALF + wr * 64 + m * 16 + fr; const f32x4 q = *(const LAS f32x4*)(red1 + r * 4);
                const float inv = 1.0f / ((q[0] + q[1]) + (q[2] + q[3])); bf16_t* rowp = P + (size_t)(row0 + ai * HALF + m * 16) * ldc + col0;
#pragma unroll
                for (int bj = 0; bj < 2; ++bj) store8_bf16(rowp + bj * HALF, acc[ai][bj][m][0] * inv, acc[ai][bj][m][1] * inv); }
    }
};

template <class Epi, class Prob, class Sched, bool ALIGN_EPI>
__device__ __forceinline__ void gemm_phase(LAS unsigned char* lds, int tid, int wid, const Prob g, const Sched& S, const Epi& E) {
    const int lane = tid & 63, wr = wid >> 2, wc = wid & 3, fr = lane & 15, fq = lane >> 4;
    const int K = g.K, nt = K / BK;
    unsigned voffA[2], voffB[2];
#pragma unroll
    for (int i = 0; i < 2; ++i) { int R, C; stage_rc(tid * 16 + i * 8192, R, C); const int Rb = Epi::PERM ? ((R & ~31) + perm32(R & 31)) : R;
        voffA[i] = (unsigned)(R * g.lda + C) * 2u; voffB[i] = (unsigned)(Rb * g.ldb + C) * 2u; }
    const size_t kstep = (size_t)(BK * 2);
    const size_t hstepA = (size_t)HALF * g.lda * 2, hstepB = (size_t)HALF * g.ldb * 2;
    const unsigned ldsw = (unsigned)wid * 1024u;
    const int aoff = lds_byte(wr * 64 + fr, fq * 8), boff = lds_byte(wc * 32 + fr, fq * 8);
#define PG8_SA(b, h) (((b) * 2 + (h)) * HTB)
#define PG8_SB(b, h) ((4 + (b) * 2 + (h)) * HTB)
#define PG8_STAGE(bufoff, gbase, voff) do { _Pragma("unroll") for (int _i = 0; _i < 2; ++_i) \
        __builtin_amdgcn_global_load_lds((const unsigned*)((const char*)(gbase) + (voff)[_i]), (LAS unsigned*)(lds + (bufoff) + ldsw + _i * 8192), 16, 0, 0); } while (0)
#define PG8_LDA(dst, b, h) do { _Pragma("unroll") for (int m = 0; m < 4; ++m) _Pragma("unroll") for (int k = 0; k < 2; ++k) dst[m][k] = *(const LAS bf16x8*)(lds + PG8_SA(b, h) + aoff + m * 2048 + k * 1024); } while (0)
#define PG8_LDB(dst, b, h) do { _Pragma("unroll") for (int n = 0; n < 2; ++n) _Pragma("unroll") for (int k = 0; k < 2; ++k) dst[n][k] = *(const LAS bf16x8*)(lds + PG8_SB(b, h) + boff + n * 2048 + k * 1024); } while (0)
#define PG8_MMA(ai, bj, At, Bt) do { __builtin_amdgcn_s_setprio(1); _Pragma("unroll") for (int m = 0; m < 4; ++m) _Pragma("unroll") for (int n = 0; n < 2; ++n) _Pragma("unroll") for (int k = 0; k < 2; ++k) \
        acc[ai][bj][m][n] = __builtin_amdgcn_mfma_f32_16x16x32_bf16(Bt[n][k], At[m][k], acc[ai][bj][m][n], 0, 0, 0); __builtin_amdgcn_s_setprio(0); } while (0)
#define PG8_WAIT_V(n) asm volatile("s_waitcnt vmcnt(" #n ")" ::: "memory")
#define PG8_WAIT_L(n) asm volatile("s_waitcnt lgkmcnt(" #n ")" ::: "memory")
#define PG8_BAR __builtin_amdgcn_s_barrier()
#define PG8_SCHED __builtin_amdgcn_sched_barrier(0)
    Unit cur, nxt; int ui = 0;
    if (!S.next(0, cur)) return;
    Acc acc;
#pragma unroll
    for (int a = 0; a < 2; ++a)
#pragma unroll
        for (int b = 0; b < 2; ++b)
#pragma unroll
            for (int m = 0; m < 4; ++m)
#pragma unroll
                for (int n = 0; n < 2; ++n) acc[a][b][m][n] = (f32x4){0.f, 0.f, 0.f, 0.f};
    bf16x8 At[4][2], B0[2][2], B1[2][2];
    const char* cA = g.a_base(cur); const char* cB = g.b_base(cur);
    PG8_STAGE(PG8_SB(0, 0), cB, voffB); PG8_STAGE(PG8_SB(0, 1), cB + hstepB, voffB); PG8_STAGE(PG8_SA(0, 0), cA, voffA); PG8_STAGE(PG8_SA(0, 1), cA + hstepA, voffA);
    if (wr == 1) PG8_BAR;
    PG8_WAIT_V(2); PG8_BAR;
    PG8_STAGE(PG8_SB(1, 0), cB + kstep, voffB); PG8_STAGE(PG8_SA(1, 0), cA + kstep, voffA); PG8_STAGE(PG8_SB(1, 1), cB + hstepB + kstep, voffB);
    PG8_WAIT_V(6); PG8_BAR;
    for (;;) {
        const bool has_next = S.next(ui + 1, nxt);
        const char* nA = has_next ? g.a_base(nxt) : cA; const char* nB = has_next ? g.b_base(nxt) : cB;
#pragma nounroll
        for (int t = 0; t < nt; t += 2) {
            const bool last = (t == nt - 2);
            const char* a1 = cA + (size_t)(t + 1) * kstep;
            const char* a2 = last ? nA : cA + (size_t)(t + 2) * kstep; const char* b2 = last ? nB : cB + (size_t)(t + 2) * kstep;
            const char* a3 = a2 + kstep; const char* b3 = b2 + kstep;
            PG8_LDB(B0, 0, 0); PG8_LDB(B1, 0, 1); PG8_SCHED; PG8_LDA(At, 0, 0); PG8_STAGE(PG8_SA(1, 1), a1 + hstepA, voffA);
            PG8_WAIT_V(8); PG8_WAIT_L(0); PG8_BAR; PG8_MMA(0, 0, At, B0); PG8_MMA(0, 1, At, B1); PG8_BAR; PG8_SCHED;
            PG8_LDA(At, 0, 1); PG8_STAGE(PG8_SB(0, 0), b2, voffB); PG8_STAGE(PG8_SB(0, 1), b2 + hstepB, voffB); PG8_STAGE(PG8_SA(0, 0), a2, voffA);
            PG8_WAIT_V(8); PG8_WAIT_L(0); PG8_BAR; PG8_MMA(1, 0, At, B0); PG8_MMA(1, 1, At, B1); PG8_BAR; PG8_SCHED;
            PG8_LDB(B0, 1, 0); PG8_LDB(B1, 1, 1); PG8_SCHED; PG8_LDA(At, 1, 0); PG8_STAGE(PG8_SA(0, 1), a2 + hstepA, voffA);
            PG8_WAIT_V(8); PG8_WAIT_L(0); PG8_BAR; PG8_MMA(0, 0, At, B0); PG8_MMA(0, 1, At, B1); PG8_BAR; PG8_SCHED;
            PG8_LDA(At, 1, 1); PG8_STAGE(PG8_SB(1, 0), b3, voffB); PG8_STAGE(PG8_SB(1, 1), b3 + hstepB, voffB); PG8_STAGE(PG8_SA(1, 0), a3, voffA);
            PG8_WAIT_V(8); PG8_WAIT_L(0); PG8_BAR; PG8_MMA(1, 0, At, B0); PG8_MMA(1, 1, At, B1); PG8_BAR; PG8_SCHED;
        }
        if constexpr (ALIGN_EPI) { if (wr == 0) PG8_BAR; }
        E(acc, cur, wr, wc, fr, fq);
        if (!has_next) break;
#pragma unroll
        for (int a = 0; a < 2; ++a)
#pragma unroll
            for (int b = 0; b < 2; ++b)
#pragma unroll
                for (int m = 0; m < 4; ++m)
#pragma unroll
                    for (int n = 0; n < 2; ++n) acc[a][b][m][n] = (f32x4){0.f, 0.f, 0.f, 0.f};
        cur = nxt; cA = nA; cB = nB; ++ui;
        if constexpr (ALIGN_EPI) { if (wr == 1) PG8_BAR; }
    }
    PG8_WAIT_V(0);
    if constexpr (!ALIGN_EPI) { if (wr == 0) PG8_BAR; }
    PG8_BAR;
#undef PG8_SA
#undef PG8_SB
#undef PG8_STAGE
#undef PG8_LDA
#undef PG8_LDB
#undef PG8_MMA
#undef PG8_WAIT_V
#undef PG8_WAIT_L
#undef PG8_BAR
#undef PG8_SCHED
}
}

struct Args { const float* in[21]; float* out; unsigned char* ws; int ph_lo, ph_hi; };
enum { I_X = 0, I_MEM, I_MIXN, I_WIN, I_CONVW, I_CONVN, I_WAF, I_BAF, I_WAB, I_BAB, I_GLAN, I_WOUT, I_XAN, I_MEMN, I_WXQ, I_WXKV, I_WXO, I_MLPN, I_WUP, I_WDN, I_FINN };
constexpr int N_PHASES = 13;

struct Ctx { LAS unsigned char* lds; int tid, lane, wave, gw, NGW, G; };

__device__ __forceinline__ void p0_transpose_item(const float* W, const float* gain, int K, int N, bf16_t* WT, LAS float* scr, int item, int lane) {
    const int nblk = N / 32, kb = item / nblk, nb = item % nblk, k0 = 64 * kb, n0 = 32 * nb;
#pragma unroll 8
    for (int i = 0; i < 32; ++i) { const int kk = 2 * i + (lane >> 5); const float g = gain ? gain[k0 + kk] : 1.0f; scr[kk * 33 + (lane & 31)] = g * W[(size_t)(k0 + kk) * N + n0 + (lane & 31)]; }
    LDS_WAIT(); asm volatile("" ::: "memory");
    const int c = lane & 7;
#pragma unroll
    for (int j = 0; j < 4; ++j) { const int n = (lane >> 3) + 8 * j; const LAS float* s = scr + (8 * c) * 33 + n;
        u32x4 o; o.x = cvt_pk_bf16(s[0 * 33], s[1 * 33]); o.y = cvt_pk_bf16(s[2 * 33], s[3 * 33]); o.z = cvt_pk_bf16(s[4 * 33], s[5 * 33]); o.w = cvt_pk_bf16(s[6 * 33], s[7 * 33]);
        *(u32x4*)(WT + (size_t)(n0 + n) * K + k0 + 8 * c) = o; }
    LDS_WAIT(); asm volatile("" ::: "memory");
}
__device__ __forceinline__ void rms_row_to_bf16(const float* xrow, const float* gain, bf16_t* orow, int lane) {
    const f32x4* xr = (const f32x4*)xrow + lane; const f32x4* gr = (const f32x4*)gain + lane;
    f32x4 v[4]; float s = 0.f;
#pragma unroll
    for (int j = 0; j < 4; ++j) { v[j] = xr[64 * j]; s += (v[j][0] * v[j][0] + v[j][1] * v[j][1]) + (v[j][2] * v[j][2] + v[j][3] * v[j][3]); }
    const float rstd = rsqrtf(wave_sum(s) * (1.f / D) + EPS);
    u32x2* o8 = (u32x2*)orow + lane;
#pragma unroll
    for (int j = 0; j < 4; ++j) { const f32x4 w = v[j] * rstd * gr[64 * j]; u32x2 pk; pk.x = cvt_pk_bf16(w[0], w[1]); pk.y = cvt_pk_bf16(w[2], w[3]); o8[64 * j] = pk; }
}
__device__ __forceinline__ void row_to_bf16_rstd(const float* xrow, bf16_t* orow, float* rstd_out, int lane) {
    const f32x4* xr = (const f32x4*)xrow + lane;
    f32x4 v[4]; float s = 0.f;
#pragma unroll
    for (int j = 0; j < 4; ++j) { v[j] = xr[64 * j]; s += (v[j][0] * v[j][0] + v[j][1] * v[j][1]) + (v[j][2] * v[j][2] + v[j][3] * v[j][3]); }
    const float rstd = rsqrtf(wave_sum(s) * (1.f / D) + EPS);
    u32x2* o8 = (u32x2*)orow + lane;
#pragma unroll
    for (int j = 0; j < 4; ++j) { u32x2 pk; pk.x = cvt_pk_bf16(v[j][0], v[j][1]); pk.y = cvt_pk_bf16(v[j][2], v[j][3]); o8[64 * j] = pk; }
    if (lane == 0) *rstd_out = rstd;
}
__device__ __forceinline__ void phase_prologue(const Ctx& c, const Args& a) {
    unsigned char* ws = a.ws;
    LAS float* scr = (LAS float*)(c.lds + c.wave * 16384);
    struct WD { const float* W; const float* g; int K, N; size_t off; };
    const WD wd[7] = { {a.in[I_WIN], a.in[I_MIXN], D, WIN, WS_WIN}, {a.in[I_WOUT], nullptr, D, D, WS_WOUT}, {a.in[I_WXQ], a.in[I_XAN], D, D, WS_WXQ}, {a.in[I_WXKV], nullptr, D, 2 * D, WS_WXKV},
                       {a.in[I_WXO], nullptr, D, D, WS_WXO}, {a.in[I_WUP], a.in[I_MLPN], D, FF, WS_WUP}, {a.in[I_WDN], nullptr, FF, D, WS_WDN} };
#pragma unroll
    for (int w = 0; w < 7; ++w) { const int nitems = (wd[w].K / 64) * (wd[w].N / 32);
        for (int it = c.gw; it < nitems; it += c.NGW) p0_transpose_item(wd[w].W, wd[w].g, wd[w].K, wd[w].N, (bf16_t*)(ws + wd[w].off), scr, it, c.lane); }
    { u32x4* z = (u32x4*)(ws + WS_WIN + (size_t)WIN * D * 2); const int n16 = (NZP - WIN) * D * 2 / 16;
      for (int i = c.gw * 64 + c.lane; i < n16; i += c.NGW * 64) z[i] = (u32x4){0u, 0u, 0u, 0u}; }
    for (int m = c.gw; m < T; m += c.NGW) row_to_bf16_rstd(a.in[I_X] + (size_t)m * D, (bf16_t*)(ws + WS_XN) + (size_t)m * D, (float*)(ws + WS_RSTD0) + m, c.lane);
    for (int m = c.gw; m < MROWS; m += c.NGW) rms_row_to_bf16(a.in[I_MEM] + (size_t)m * D, a.in[I_MEMN], (bf16_t*)(ws + WS_MN) + (size_t)m * D, c.lane);
}

constexpr int GS = 144;
constexpr int L_QF = 0, L_KF = 9216, L_QB = 18432, L_KB = 27648, L_VT = 36864, L_AC = 55296, L_RED = 64512, L_WA = 66560, L_WB = 74752;
__device__ __forceinline__ bf16x8 gfrag(const LAS unsigned char* base, int r0, int ks, int fr, int fq) { return *(const LAS bf16x8*)(base + (r0 + fr) * GS + ks * 64 + fq * 16); }
__device__ __forceinline__ float logsig(float z) { return fminf(z, 0.f) - __logf(1.0f + __expf(-fabsf(z))); }

__device__ __forceinline__ void gla_load_w(const Ctx& c, const Args& a, int h) {
    const int idx = c.tid * 4, dir = idx >> 10, r = (idx >> 6) & 15, d = idx & 63;
    const float* src = (dir ? a.in[I_WAB] : a.in[I_WAF]) + r * 256 + h * 64 + d;
    *(LAS f32x4*)(c.lds + L_WA + idx * 4) = *(const f32x4*)src;
    if (c.tid < 32) { const int dr = c.tid >> 4, dd = (c.tid & 15) * 4; *(LAS f32x4*)(c.lds + L_WB + (dr * 64 + dd) * 4) = *(const f32x4*)((dr ? a.in[I_BAB] : a.in[I_BAF]) + h * 64 + dd); }
}
template <bool PASS_A>
__device__ __forceinline__ void gla_prep(const Ctx& c, const Args& a, int b, int h, int n, float* Gf, float* Gb) {
    const bf16_t* Z = (const bf16_t*)(a.ws + WS_Z); const float* LR = (const float*)(a.ws + WS_LR);
    const int t = c.lane, d0 = 8 * c.wave; const size_t row = (size_t)b * SEQ + n * 64 + t;
    const f32x4* lrp = (const f32x4*)(LR + row * 32);
    f32x4 l[8];
#pragma unroll
    for (int i = 0; i < 8; ++i) l[i] = lrp[i];
    const u32x4 qraw = *(const u32x4*)(Z + row * NZ + ZQ + h * 64 + d0), kraw = *(const u32x4*)(Z + row * NZ + ZK + h * 64 + d0);
    float qv[8], kv[8];
#pragma unroll
    for (int i = 0; i < 4; ++i) { qv[2 * i] = bf_lo(qraw[i]); qv[2 * i + 1] = bf_hi(qraw[i]); kv[2 * i] = bf_lo(kraw[i]); kv[2 * i + 1] = bf_hi(kraw[i]); }
    const LAS float* WA = (const LAS float*)(c.lds + L_WA); const LAS float* WB = (const LAS float*)(c.lds + L_WB);
    float zf[8], zb[8];
    { const f32x4 b0 = *(const LAS f32x4*)(WB + d0), b1 = *(const LAS f32x4*)(WB + d0 + 4), b2 = *(const LAS f32x4*)(WB + 64 + d0), b3 = *(const LAS f32x4*)(WB + 64 + d0 + 4);
#pragma unroll
      for (int i = 0; i < 4; ++i) { zf[i] = b0[i]; zf[4 + i] = b1[i]; zb[i] = b2[i]; zb[4 + i] = b3[i]; } }
#pragma unroll
    for (int r = 0; r < 16; ++r) {
        const f32x4 f0 = *(const LAS f32x4*)(WA + r * 64 + d0), f1 = *(const LAS f32x4*)(WA + r * 64 + d0 + 4);
        const f32x4 g0 = *(const LAS f32x4*)(WA + 1024 + r * 64 + d0), g1 = *(const LAS f32x4*)(WA + 1024 + r * 64 + d0 + 4);
        const float lf = l[r >> 2][r & 3], lb = l[4 + (r >> 2)][r & 3];
#pragma unroll
        for (int i = 0; i < 4; ++i) { zf[i] += lf * f0[i]; zf[4 + i] += lf * f1[i]; zb[i] += lb * g0[i]; zb[4 + i] += lb * g1[i]; }
        if (r & 1) {
#pragma unroll
            for (int i = 0; i < 8; ++i) asm volatile("" : "+v"(zf[i]), "+v"(zb[i])); }
    }
    float o0[8], o1[8], o2[8], o3[8];
#pragma unroll
    for (int i = 0; i < 8; ++i) {
        float bb = logsig(zf[i]) * (1.0f / 16.0f), cc = logsig(zb[i]) * (1.0f / 16.0f);
#pragma unroll
        for (int off = 1; off < 64; off <<= 1) { const float y = __shfl_up(bb, off); if (t >= off) bb += y; const float w = __shfl_down(cc, off); if (t + off < 64) cc += w; }
        if (PASS_A) {
            const float b63 = __shfl(bb, 63), c0 = __shfl(cc, 0);
            o0[i] = kv[i] * __expf(b63 - bb); o1[i] = kv[i] * __expf(c0 - cc);
            if (t == 63) Gf[d0 + i] = bb;
            if (t == 0) Gb[d0 + i] = cc;
        } else {
            const float eb = __expf(bb), ec = __expf(cc);
            o0[i] = qv[i] * 0.125f * eb; o1[i] = kv[i] * __expf(-bb); o2[i] = qv[i] * 0.125f * ec; o3[i] = kv[i] * __expf(-cc);
        }
    }
    if (PASS_A) {
#pragma unroll
        for (int i = 0; i < 8; i += 2) { const unsigned pf = cvt_pk_bf16(o0[i], o0[i + 1]), pb = cvt_pk_bf16(o1[i], o1[i + 1]);
            *(LAS bf16_t*)(c.lds + L_QF + (d0 + i) * GS + t * 2) = (bf16_t)(pf & 0xffffu); *(LAS bf16_t*)(c.lds + L_QF + (d0 + i + 1) * GS + t * 2) = (bf16_t)(pf >> 16);
            *(LAS bf16_t*)(c.lds + L_KF + (d0 + i) * GS + t * 2) = (bf16_t)(pb & 0xffffu); *(LAS bf16_t*)(c.lds + L_KF + (d0 + i + 1) * GS + t * 2) = (bf16_t)(pb >> 16); }
    } else {
        u32x4 w0, w1, w2, w3;
#pragma unroll
        for (int i = 0; i < 4; ++i) { w0[i] = cvt_pk_bf16(o0[2 * i], o0[2 * i + 1]); w1[i] = cvt_pk_bf16(o1[2 * i], o1[2 * i + 1]); w2[i] = cvt_pk_bf16(o2[2 * i], o2[2 * i + 1]); w3[i] = cvt_pk_bf16(o3[2 * i], o3[2 * i + 1]); }
        *(LAS u32x4*)(c.lds + L_QF + t * GS + d0 * 2) = w0; *(LAS u32x4*)(c.lds + L_KF + t * GS + d0 * 2) = w1;
        *(LAS u32x4*)(c.lds + L_QB + t * GS + d0 * 2) = w2; *(LAS u32x4*)(c.lds + L_KB + t * GS + d0 * 2) = w3;
    }
    const int e0 = 16 * c.wave; const u32x4* vp = (const u32x4*)(Z + row * NZ + ZV + h * 128 + e0);
    const u32x4 va = vp[0], vb = vp[1];
#pragma unroll
    for (int i = 0; i < 4; ++i) {
        *(LAS bf16_t*)(c.lds + L_VT + (e0 + 2 * i) * GS + t * 2) = (bf16_t)(va[i] & 0xffffu); *(LAS bf16_t*)(c.lds + L_VT + (e0 + 2 * i + 1) * GS + t * 2) = (bf16_t)(va[i] >> 16);
        *(LAS bf16_t*)(c.lds + L_VT + (e0 + 8 + 2 * i) * GS + t * 2) = (bf16_t)(vb[i] & 0xffffu); *(LAS bf16_t*)(c.lds + L_VT + (e0 + 8 + 2 * i + 1) * GS + t * 2) = (bf16_t)(vb[i] >> 16); }
}

__device__ __forceinline__ void phase_gla_a(const Ctx& c, const Args& a) {
    float* UU = (float*)(a.ws + WS_UU); float* GG = (float*)(a.ws + WS_GG);
    const int fr = c.lane & 15, fq = c.lane >> 4, w = c.wave;
    int h_loaded = -1;
    for (int uu = blockIdx.x; uu < NUNIT; uu += c.G) {
        const int h = uu & 3, n = (uu >> 2) & (NCH - 1), b = uu >> 9, unit = (b * GH + h) * NCH + n;
        __syncthreads();
        if (h != h_loaded) { gla_load_w(c, a, h); h_loaded = h; __syncthreads(); }
        gla_prep<true>(c, a, b, h, n, GG + (size_t)unit * 64, GG + (size_t)(NUNIT + unit) * 64);
        __syncthreads();
        bf16x8 av[2];
#pragma unroll
        for (int ks = 0; ks < 2; ++ks) av[ks] = gfrag(c.lds + L_VT, 16 * w, ks, fr, fq);
#pragma unroll
        for (int dir = 0; dir < 2; ++dir)
#pragma unroll
            for (int dt = 0; dt < 4; ++dt) { f32x4 acc = (f32x4){0.f, 0.f, 0.f, 0.f};
#pragma unroll
                for (int ks = 0; ks < 2; ++ks) acc = __builtin_amdgcn_mfma_f32_16x16x32_bf16(av[ks], gfrag(c.lds + (dir ? L_KF : L_QF), 16 * dt, ks, fr, fq), acc, 0, 0, 0);
                float* up = UU + ((size_t)(dir * NUNIT + unit) * 128 + 16 * w + 4 * fq) * 64 + 16 * dt + fr;
#pragma unroll
                for (int i = 0; i < 4; ++i) up[i * 64] = acc[i]; }
    }
}
constexpr int NSC = 16, SCN = 8;
constexpr int M_QF = 0, M_KF = 9216, M_QB = 18432, M_KB = 27648, M_QB2 = 36864, M_VT = 46080, M_AC = 64512, M_KHF = 73728, M_KHB = 82944, M_RED = 92160,
              M_WA = 94208, M_WB = 102400, M_GF = 102912, M_GB = 103168, M_LC = 103424;
constexpr size_t WS_RS = WS_SS;
constexpr size_t WS_TT = WS_UU;
constexpr size_t WS_LC = WS_GG;
constexpr size_t WS_AFB = WS_GG + 512 * 1024;

__device__ __forceinline__ float wave_prefix_sum(float v) {
#define DPP_ADD(ctrl, rmask) v += __int_as_float(__builtin_amdgcn_update_dpp(0, __float_as_int(v), ctrl, rmask, 0xf, false))
    DPP_ADD(0x111, 0xf); DPP_ADD(0x112, 0xf); DPP_ADD(0x114, 0xf); DPP_ADD(0x118, 0xf); DPP_ADD(0x142, 0xa); DPP_ADD(0x143, 0xc);
#undef DPP_ADD
    return v;
}
__device__ __forceinline__ void gla_load_w2(const Ctx& c, const Args& a, int h) {
    const int idx = c.tid * 4, dir = idx >> 10, r = (idx >> 6) & 15, d = idx & 63;
    const float* src = (dir ? a.in[I_WAB] : a.in[I_WAF]) + r * 256 + h * 64 + d;
    *(LAS f32x4*)(c.lds + M_WA + idx * 4) = *(const f32x4*)src;
    if (c.tid < 32) { const int dr = c.tid >> 4, dd = (c.tid & 15) * 4; *(LAS f32x4*)(c.lds + M_WB + (dr * 64 + dd) * 4) = *(const f32x4*)((dr ? a.in[I_BAB] : a.in[I_BAF]) + h * 64 + dd); }
}
struct PrepIn { f32x4 l[8]; u32x4 q, k, va, vb; };
__device__ __forceinline__ void gla_prep_load(PrepIn& in, const Ctx& c, const Args& a, int b, int h, int chunk) {
    const bf16_t* Z = (const bf16_t*)(a.ws + WS_Z); const float* LR = (const float*)(a.ws + WS_LR);
    const size_t row = (size_t)b * SEQ + chunk * 64 + c.lane; const f32x4* lrp = (const f32x4*)(LR + row * 32);
#pragma unroll
    for (int i = 0; i < 8; ++i) in.l[i] = lrp[i];
    in.q = *(const u32x4*)(Z + row * NZ + ZQ + h * 64 + 8 * c.wave); in.k = *(const u32x4*)(Z + row * NZ + ZK + h * 64 + 8 * c.wave);
    const u32x4* vp = (const u32x4*)(Z + row * NZ + ZV + h * 128 + 16 * c.wave); in.va = vp[0]; in.vb = vp[1];
}
template <bool MODE_A>
__device__ __forceinline__ void gla_prep2(const Ctx& c, const PrepIn& in, const f32x4 lc0, const f32x4 lc1) {
    const int t = c.lane, d0 = 8 * c.wave;
    float qv[8], kv[8];
#pragma unroll
    for (int i = 0; i < 4; ++i) { qv[2 * i] = bf_lo(in.q[i]); qv[2 * i + 1] = bf_hi(in.q[i]); kv[2 * i] = bf_lo(in.k[i]); kv[2 * i + 1] = bf_hi(in.k[i]); }
    const LAS float* WA = (const LAS float*)(c.lds + M_WA); const LAS float* WB = (const LAS float*)(c.lds + M_WB);
    float zf[8], zb[8];
    { const f32x4 b0 = *(const LAS f32x4*)(WB + d0), b1 = *(const LAS f32x4*)(WB + d0 + 4), b2 = *(const LAS f32x4*)(WB + 64 + d0), b3 = *(const LAS f32x4*)(WB + 64 + d0 + 4);
#pragma unroll
      for (int i = 0; i < 4; ++i) { zf[i] = b0[i]; zf[4 + i] = b1[i]; zb[i] = b2[i]; zb[4 + i] = b3[i]; } }
#pragma unroll
    for (int r = 0; r < 16; ++r) {
        const f32x4 f0 = *(const LAS f32x4*)(WA + r * 64 + d0), f1 = *(const LAS f32x4*)(WA + r * 64 + d0 + 4);
        const f32x4 g0 = *(const LAS f32x4*)(WA + 1024 + r * 64 + d0), g1 = *(const LAS f32x4*)(WA + 1024 + r * 64 + d0 + 4);
        const float lf = in.l[r >> 2][r & 3], lb = in.l[4 + (r >> 2)][r & 3];
#pragma unroll
        for (int i = 0; i < 4; ++i) { zf[i] += lf * f0[i]; zf[4 + i] += lf * f1[i]; zb[i] += lb * g0[i]; zb[4 + i] += lb * g1[i]; }
        if (r & 1) {
#pragma unroll
            for (int i = 0; i < 8; ++i) asm volatile("" : "+v"(zf[i]), "+v"(zb[i])); }
    }
    float o0[8], o1[8], o2[8], o3[8], o4[8], o5[8], gft[8], gbt[8];
#pragma unroll
    for (int i = 0; i < 8; ++i) {
        const float laf = logsig(zf[i]) * (1.0f / 16.0f), lab = logsig(zb[i]) * (1.0f / 16.0f);
        const float pf = wave_prefix_sum(laf), pb = wave_prefix_sum(lab);
        const float Gf = __int_as_float(__builtin_amdgcn_readlane(__float_as_int(pf), 63)), Gb = __int_as_float(__builtin_amdgcn_readlane(__float_as_int(pb), 63));
        gft[i] = Gf; gbt[i] = Gb;
        o4[i] = kv[i] * __expf(Gf - pf);
        if (MODE_A) { o5[i] = kv[i] * __expf(pb - lab); }
        else { const float cc = Gb - pb + lab, lcv = (i < 4) ? lc0[i & 3] : lc1[i & 3], q8 = qv[i] * 0.125f;
            o0[i] = q8 * __expf(pf); o1[i] = kv[i] * __expf(-pf); o2[i] = q8 * __expf(cc); o3[i] = kv[i] * __expf(-cc); o5[i] = q8 * __expf(cc + lcv); }
    }
#pragma unroll
    for (int i = 0; i < 8; i += 2) { const unsigned pf = cvt_pk_bf16(o4[i], o4[i + 1]);
        *(LAS bf16_t*)(c.lds + M_KHF + (d0 + i) * GS + t * 2) = (bf16_t)(pf & 0xffffu); *(LAS bf16_t*)(c.lds + M_KHF + (d0 + i + 1) * GS + t * 2) = (bf16_t)(pf >> 16);
        if (MODE_A) { const unsigned pb = cvt_pk_bf16(o5[i], o5[i + 1]);
            *(LAS bf16_t*)(c.lds + M_KHB + (d0 + i) * GS + t * 2) = (bf16_t)(pb & 0xffffu); *(LAS bf16_t*)(c.lds + M_KHB + (d0 + i + 1) * GS + t * 2) = (bf16_t)(pb >> 16); } }
    if (!MODE_A) {
        u32x4 w0, w1, w2, w3, w4;
#pragma unroll
        for (int i = 0; i < 4; ++i) { w0[i] = cvt_pk_bf16(o0[2 * i], o0[2 * i + 1]); w1[i] = cvt_pk_bf16(o1[2 * i], o1[2 * i + 1]); w2[i] = cvt_pk_bf16(o2[2 * i], o2[2 * i + 1]);
                                      w3[i] = cvt_pk_bf16(o3[2 * i], o3[2 * i + 1]); w4[i] = cvt_pk_bf16(o5[2 * i], o5[2 * i + 1]); }
        *(LAS u32x4*)(c.lds + M_QF + t * GS + d0 * 2) = w0; *(LAS u32x4*)(c.lds + M_KF + t * GS + d0 * 2) = w1;
        *(LAS u32x4*)(c.lds + M_QB + t * GS + d0 * 2) = w2; *(LAS u32x4*)(c.lds + M_KB + t * GS + d0 * 2) = w3; *(LAS u32x4*)(c.lds + M_QB2 + t * GS + d0 * 2) = w4;
    }
    if (t == 63) { *(LAS f32x4*)(c.lds + M_GF + d0 * 4) = (f32x4){gft[0], gft[1], gft[2], gft[3]}; *(LAS f32x4*)(c.lds + M_GF + d0 * 4 + 16) = (f32x4){gft[4], gft[5], gft[6], gft[7]};
        if (MODE_A) { *(LAS f32x4*)(c.lds + M_GB + d0 * 4) = (f32x4){gbt[0], gbt[1], gbt[2], gbt[3]}; *(LAS f32x4*)(c.lds + M_GB + d0 * 4 + 16) = (f32x4){gbt[4], gbt[5], gbt[6], gbt[7]}; } }
    const int e0 = 16 * c.wave;
#pragma unroll
    for (int i = 0; i < 4; ++i) {
        *(LAS bf16_t*)(c.lds + M_VT + (e0 + 2 * i) * GS + t * 2) = (bf16_t)(in.va[i] & 0xffffu); *(LAS bf16_t*)(c.lds + M_VT + (e0 + 2 * i + 1) * GS + t * 2) = (bf16_t)(in.va[i] >> 16);
        *(LAS bf16_t*)(c.lds + M_VT + (e0 + 8 + 2 * i) * GS + t * 2) = (bf16_t)(in.vb[i] & 0xffffu); *(LAS bf16_t*)(c.lds + M_VT + (e0 + 8 + 2 * i + 1) * GS + t * 2) = (bf16_t)(in.vb[i] >> 16); }
}
#define GLA_BAR() do { LDS_WAIT(); __builtin_amdgcn_s_barrier(); asm volatile("" ::: "memory"); } while (0)
__device__ __forceinline__ f32x4 exp4(f32x4 v) { return (f32x4){__expf(v[0]), __expf(v[1]), __expf(v[2]), __expf(v[3])}; }
__device__ __forceinline__ bf16x8 pack_frag(f32x4 lo, f32x4 hi) { u32x4 w; w.x = cvt_pk_bf16(lo[0], lo[1]); w.y = cvt_pk_bf16(lo[2], lo[3]); w.z = cvt_pk_bf16(hi[0], hi[1]); w.w = cvt_pk_bf16(hi[2], hi[3]); return __builtin_bit_cast(bf16x8, w); }

__device__ __forceinline__ void phase_gla_A2(const Ctx& c, const Args& a) {
    bf16_t* RS = (bf16_t*)(a.ws + WS_RS); float* TT = (float*)(a.ws + WS_TT); float* LCg = (float*)(a.ws + WS_LC); float* AFB = (float*)(a.ws + WS_AFB);
    const int fr = c.lane & 15, fq = c.lane >> 4, w = c.wave;
    int h_loaded = -1;
    for (int uu = blockIdx.x; uu < BATCH * GH * NSC; uu += c.G) {
        const int h = uu & 3, sc = (uu >> 2) & (NSC - 1), b = uu >> 6, bh = b * GH + h, u16 = bh * NSC + sc;
        __syncthreads();
        if (h != h_loaded) { gla_load_w2(c, a, h); h_loaded = h; }
        if (c.tid < 64) *(LAS float*)(c.lds + M_LC + c.tid * 4) = 0.f;
        __syncthreads();
        f32x4 Tf[4], Tb[4], Lf[4];
#pragma unroll
        for (int dt = 0; dt < 4; ++dt) { Tf[dt] = (f32x4){0.f, 0.f, 0.f, 0.f}; Tb[dt] = Tf[dt]; Lf[dt] = Tf[dt]; }
        PrepIn in; gla_prep_load(in, c, a, b, h, sc * SCN + SCN - 1);
        for (int n = SCN - 1; n >= 0; --n) {
            const int chunk = sc * SCN + n; const size_t cg_ = (size_t)bh * NCH + chunk;
            gla_prep2<true>(c, in, (f32x4){0.f, 0.f, 0.f, 0.f}, (f32x4){0.f, 0.f, 0.f, 0.f});
            if (n > 0) gla_prep_load(in, c, a, b, h, chunk - 1);
            GLA_BAR();
#pragma unroll
            for (int dt = 0; dt < 4; ++dt) { u32x2 pk; pk.x = cvt_pk_bf16(Tb[dt][0], Tb[dt][1]); pk.y = cvt_pk_bf16(Tb[dt][2], Tb[dt][3]);
                *(u32x2*)(RS + (cg_ * 128 + 16 * w + fr) * 64 + 16 * dt + 4 * fq) = pk; }
            if (c.tid < 64) { LAS float* lcs = (LAS float*)(c.lds + M_LC) + c.tid; const float v = *lcs; LCg[cg_ * 64 + c.tid] = v; *lcs = v + *((const LAS float*)(c.lds + M_GB) + c.tid); }
            bf16x8 bv[2];
#pragma unroll
            for (int ks = 0; ks < 2; ++ks) bv[ks] = gfrag(c.lds + M_VT, 16 * w, ks, fr, fq);
#pragma unroll
            for (int dt = 0; dt < 4; ++dt) { f32x4 uf = (f32x4){0.f, 0.f, 0.f, 0.f}, ub = uf;
#pragma unroll
                for (int ks = 0; ks < 2; ++ks) { uf = __builtin_amdgcn_mfma_f32_16x16x32_bf16(gfrag(c.lds + M_KHF, 16 * dt, ks, fr, fq), bv[ks], uf, 0, 0, 0);
                                                  ub = __builtin_amdgcn_mfma_f32_16x16x32_bf16(gfrag(c.lds + M_KHB, 16 * dt, ks, fr, fq), bv[ks], ub, 0, 0, 0); }
                const f32x4 gf4 = *(const LAS f32x4*)(c.lds + M_GF + (16 * dt + 4 * fq) * 4), gb4 = *(const LAS f32x4*)(c.lds + M_GB + (16 * dt + 4 * fq) * 4);
                Tb[dt] = exp4(gb4) * Tb[dt] + ub; Tf[dt] = Tf[dt] + exp4(Lf[dt]) * uf; Lf[dt] = Lf[dt] + gf4; }
            GLA_BAR();
        }
#pragma unroll
        for (int dt = 0; dt < 4; ++dt) { const size_t o = ((size_t)u16 * 128 + 16 * w + fr) * 64 + 16 * dt + 4 * fq;
            *(f32x4*)(TT + o) = Tf[dt]; *(f32x4*)(TT + (size_t)256 * 8192 + o) = Tb[dt];
            if (w == 0 && fr == 0) *(f32x4*)(AFB + (size_t)u16 * 64 + 16 * dt + 4 * fq) = Lf[dt]; }
        if (c.tid < 64) AFB[(size_t)(256 + u16) * 64 + c.tid] = *((const LAS float*)(c.lds + M_LC) + c.tid);
    }
}
__device__ __forceinline__ bf16x8 gfrag_perm(const LAS unsigned char* base, int r0, int ks, int fr, int fq) {
    const LAS unsigned char* p = base + (r0 + fr) * GS + ks * 64 + fq * 8; const u32x2 lo = *(const LAS u32x2*)p, hi = *(const LAS u32x2*)(p + 32);
    return __builtin_bit_cast(bf16x8, (u32x4){lo.x, lo.y, hi.x, hi.y});
}
__device__ __forceinline__ void phase_gla_B2(const Ctx& c, const Args& a) {
    const bf16_t* Z = (const bf16_t*)(a.ws + WS_Z); const bf16_t* RS = (const bf16_t*)(a.ws + WS_RS); const float* TT = (const float*)(a.ws + WS_TT);
    const float* LCg = (const float*)(a.ws + WS_LC); const float* AFB = (const float*)(a.ws + WS_AFB); bf16_t* Y = (bf16_t*)(a.ws + WS_Y);
    const int fr = c.lane & 15, fq = c.lane >> 4, w = c.wave;
    const f32x4 gnv = *(const f32x4*)(a.in[I_GLAN] + 16 * w + 4 * fq);
    LAS float* red = (LAS float*)(c.lds + M_RED);
    int h_loaded = -1;
    for (int uu = blockIdx.x; uu < BATCH * GH * NSC; uu += c.G) {
        const int h = uu & 3, sc = (uu >> 2) & (NSC - 1), b = uu >> 6, bh = b * GH + h;
        __syncthreads();
        if (h != h_loaded) { gla_load_w2(c, a, h); h_loaded = h; }
        __syncthreads();
        PrepIn in; gla_prep_load(in, c, a, b, h, sc * SCN);
        f32x4 Sf[4], Sb[4];
#pragma unroll
        for (int dt = 0; dt < 4; ++dt) { Sf[dt] = (f32x4){0.f, 0.f, 0.f, 0.f}; Sb[dt] = Sf[dt]; }
        for (int s2 = 0; s2 < sc; ++s2) { const size_t u2 = (size_t)bh * NSC + s2;
#pragma unroll
            for (int dt = 0; dt < 4; ++dt) { const f32x4 af = *(const f32x4*)(AFB + u2 * 64 + 16 * dt + 4 * fq), tf = *(const f32x4*)(TT + (u2 * 128 + 16 * w + fr) * 64 + 16 * dt + 4 * fq);
                Sf[dt] = exp4(af) * Sf[dt] + tf; } }
        for (int s2 = NSC - 1; s2 > sc; --s2) { const size_t u2 = (size_t)bh * NSC + s2;
#pragma unroll
            for (int dt = 0; dt < 4; ++dt) { const f32x4 ab = *(const f32x4*)(AFB + (256 + u2) * 64 + 16 * dt + 4 * fq), tb = *(const f32x4*)(TT + (size_t)256 * 8192 + (u2 * 128 + 16 * w + fr) * 64 + 16 * dt + 4 * fq);
                Sb[dt] = exp4(ab) * Sb[dt] + tb; } }
        bf16x8 asb[2];
#pragma unroll
        for (int ks = 0; ks < 2; ++ks) asb[ks] = pack_frag(Sb[2 * ks], Sb[2 * ks + 1]);
        for (int n = 0; n < SCN; ++n) {
            const int chunk = sc * SCN + n; const size_t cg_ = (size_t)bh * NCH + chunk;
            const f32x4 lc0 = *(const f32x4*)(LCg + cg_ * 64 + 8 * w), lc1 = *(const f32x4*)(LCg + cg_ * 64 + 8 * w + 4);
            gla_prep2<false>(c, in, lc0, lc1);
            if (n + 1 < SCN) gla_prep_load(in, c, a, b, h, chunk + 1);
            bf16x8 rfr[2], asf[2]; u32x2 gr[4];
#pragma unroll
            for (int ks = 0; ks < 2; ++ks) { rfr[ks] = *(const bf16x8*)(RS + (cg_ * 128 + 16 * w + fr) * 64 + 32 * ks + 8 * fq); asf[ks] = pack_frag(Sf[2 * ks], Sf[2 * ks + 1]); }
#pragma unroll
            for (int tt = 0; tt < 4; ++tt) gr[tt] = *(const u32x2*)(Z + ((size_t)b * SEQ + chunk * 64 + 16 * tt + fr) * NZ + ZG + h * 128 + 16 * w + 4 * fq);
            GLA_BAR();
            { const int tt = w & 3;
#pragma unroll
              for (int s2 = 0; s2 < 2; ++s2) { const int ss = 2 * (w >> 2) + s2; f32x4 af = (f32x4){0.f, 0.f, 0.f, 0.f}, ab = af;
                  if (ss <= tt) {
#pragma unroll
                      for (int ks = 0; ks < 2; ++ks) af = __builtin_amdgcn_mfma_f32_16x16x32_bf16(gfrag(c.lds + M_KF, 16 * ss, ks, fr, fq), gfrag(c.lds + M_QF, 16 * tt, ks, fr, fq), af, 0, 0, 0); }
                  if (ss >= tt) {
#pragma unroll
                      for (int ks = 0; ks < 2; ++ks) ab = __builtin_amdgcn_mfma_f32_16x16x32_bf16(gfrag(c.lds + M_KB, 16 * ss, ks, fr, fq), gfrag(c.lds + M_QB, 16 * tt, ks, fr, fq), ab, 0, 0, 0); }
                  const int tpos = 16 * tt + fr, s0 = 16 * ss + 4 * fq; float v[4];
#pragma unroll
                  for (int i = 0; i < 4; ++i) v[i] = (s0 + i <= tpos) ? af[i] : ab[i];
                  u32x2 pk; pk.x = cvt_pk_bf16(v[0], v[1]); pk.y = cvt_pk_bf16(v[2], v[3]);
                  *(LAS u32x2*)(c.lds + M_AC + tpos * GS + s0 * 2) = pk; } }
            GLA_BAR();
            bf16x8 av[2];
#pragma unroll
            for (int ks = 0; ks < 2; ++ks) av[ks] = gfrag(c.lds + M_VT, 16 * w, ks, fr, fq);
            f32x4 o[4];
#pragma unroll
            for (int tt = 0; tt < 4; ++tt) { f32x4 acc = (f32x4){0.f, 0.f, 0.f, 0.f};
#pragma unroll
                for (int ks = 0; ks < 2; ++ks) { acc = __builtin_amdgcn_mfma_f32_16x16x32_bf16(av[ks], gfrag(c.lds + M_AC, 16 * tt, ks, fr, fq), acc, 0, 0, 0);
                    acc = __builtin_amdgcn_mfma_f32_16x16x32_bf16(asf[ks], gfrag_perm(c.lds + M_QF, 16 * tt, ks, fr, fq), acc, 0, 0, 0);
                    acc = __builtin_amdgcn_mfma_f32_16x16x32_bf16(rfr[ks], gfrag(c.lds + M_QB, 16 * tt, ks, fr, fq), acc, 0, 0, 0);
                    acc = __builtin_amdgcn_mfma_f32_16x16x32_bf16(asb[ks], gfrag_perm(c.lds + M_QB2, 16 * tt, ks, fr, fq), acc, 0, 0, 0); }
                o[tt] = acc;
                float p = (acc[0] * acc[0] + acc[1] * acc[1]) + (acc[2] * acc[2] + acc[3] * acc[3]);
                p += __shfl_xor(p, 16); p += __shfl_xor(p, 32);
                if (fq == 0) red[w * 64 + 16 * tt + fr] = p; }
#pragma unroll
            for (int dt = 0; dt < 4; ++dt) { f32x4 uf = (f32x4){0.f, 0.f, 0.f, 0.f};
#pragma unroll
                for (int ks = 0; ks < 2; ++ks) uf = __builtin_amdgcn_mfma_f32_16x16x32_bf16(gfrag(c.lds + M_KHF, 16 * dt, ks, fr, fq), av[ks], uf, 0, 0, 0);
                const f32x4 gf4 = *(const LAS f32x4*)(c.lds + M_GF + (16 * dt + 4 * fq) * 4);
                Sf[dt] = exp4(gf4) * Sf[dt] + uf; }
            GLA_BAR();
#pragma unroll
            for (int tt = 0; tt < 4; ++tt) { const int tpos = 16 * tt + fr; float s = 0.f;
#pragma unroll
                for (int ww = 0; ww < 8; ++ww) s += red[ww * 64 + tpos];
                const float rstd = rsqrtf(s * (1.0f / 128.0f) + EPS);
                const size_t row = (size_t)b * SEQ + chunk * 64 + tpos;
                const float g4[4] = {bf_lo(gr[tt].x), bf_hi(gr[tt].x), bf_lo(gr[tt].y), bf_hi(gr[tt].y)}; float y[4];
#pragma unroll
                for (int i = 0; i < 4; ++i) y[i] = o[tt][i] * rstd * gnv[i] * (g4[i] / (1.0f + __expf(-g4[i])));
                u32x2 pk; pk.x = cvt_pk_bf16(y[0], y[1]); pk.y = cvt_pk_bf16(y[2], y[3]);
                *(u32x2*)(Y + row * D + 512 + h * 128 + 16 * w + 4 * fq) = pk; }
            GLA_BAR();
        }
    }
}
__device__ __forceinline__ void phase_conv(const Ctx& c, const Args& a) {
    const bf16_t* Z = (const bf16_t*)(a.ws + WS_Z); bf16_t* Y = (bf16_t*)(a.ws + WS_Y);
    const float* cw = a.in[I_CONVW]; const float* cn = a.in[I_CONVN];
    const int c0 = 8 * c.lane;
    float w0[8], w1[8], w2[8], gn[8];
#pragma unroll
    for (int i = 0; i < 8; ++i) { w0[i] = cw[c0 + i]; w1[i] = cw[512 + c0 + i]; w2[i] = cw[1024 + c0 + i]; gn[i] = cn[c0 + i]; }
    for (int tok = c.gw; tok < T; tok += c.NGW) {
        const int s = tok % SEQ; const bf16_t* zr = Z + (size_t)tok * NZ + c0;
        const u32x4 cb = *(const u32x4*)(zr + ZCB), cc0 = *(const u32x4*)(zr + ZCC), cu0 = *(const u32x4*)(zr + ZCU);
        u32x4 ccm = (u32x4){0u, 0u, 0u, 0u}, cum = ccm, ccp = ccm, cup = ccm;
        if (s > 0) { ccm = *(const u32x4*)(zr - NZ + ZCC); cum = *(const u32x4*)(zr - NZ + ZCU); }
        if (s < SEQ - 1) { ccp = *(const u32x4*)(zr + NZ + ZCC); cup = *(const u32x4*)(zr + NZ + ZCU); }
        float y[8]; float ss = 0.f;
#pragma unroll
        for (int i = 0; i < 4; ++i) {
            const float hm0 = bf_lo(ccm[i]) * bf_lo(cum[i]), hm1 = bf_hi(ccm[i]) * bf_hi(cum[i]);
            const float h00 = bf_lo(cc0[i]) * bf_lo(cu0[i]), h01 = bf_hi(cc0[i]) * bf_hi(cu0[i]);
            const float hp0 = bf_lo(ccp[i]) * bf_lo(cup[i]), hp1 = bf_hi(ccp[i]) * bf_hi(cup[i]);
            y[2 * i] = bf_lo(cb[i]) * (w0[2 * i] * hm0 + w1[2 * i] * h00 + w2[2 * i] * hp0);
            y[2 * i + 1] = bf_hi(cb[i]) * (w0[2 * i + 1] * hm1 + w1[2 * i + 1] * h01 + w2[2 * i + 1] * hp1);
            ss += y[2 * i] * y[2 * i] + y[2 * i + 1] * y[2 * i + 1]; }
        ss += __shfl_xor(ss, 1); ss += __shfl_xor(ss, 2); ss += __shfl_xor(ss, 4);
        const float rstd = rsqrtf(ss * (1.0f / 64.0f) + EPS);
        u32x4 o;
#pragma unroll
        for (int i = 0; i < 4; ++i) o[i] = cvt_pk_bf16(y[2 * i] * rstd * gn[2 * i], y[2 * i + 1] * rstd * gn[2 * i + 1]);
        *(u32x4*)(Y + (size_t)tok * D + c0) = o;
    }
}
__device__ __forceinline__ void phase_scan(const Ctx& c, const Args& a) {
    const float* UU = (const float*)(a.ws + WS_UU); const float* GG = (const float*)(a.ws + WS_GG); bf16_t* SS = (bf16_t*)(a.ws + WS_SS);
    const int nthreads = c.G * 512;
    for (int idx = blockIdx.x * 512 + c.tid; idx < 2 * 16 * 8192; idx += nthreads) {
        const int dir = idx / (16 * 8192), rem = idx % (16 * 8192), bh = rem / 8192, ed = rem % 8192, d = ed & 63;
        const size_t ubase = (size_t)dir * NUNIT + (size_t)bh * NCH;
        float S = 0.f;
        for (int n0 = 0; n0 < NCH; n0 += 8) {
            float u[8], g[8];
#pragma unroll
            for (int j = 0; j < 8; ++j) { const int n = dir ? (NCH - 1 - (n0 + j)) : (n0 + j); u[j] = UU[(ubase + n) * 8192 + ed]; g[j] = GG[(ubase + n) * 64 + d]; }
#pragma unroll
            for (int j = 0; j < 8; ++j) { const int n = dir ? (NCH - 1 - (n0 + j)) : (n0 + j);
                SS[(ubase + n) * 8192 + ed] = (bf16_t)(cvt_pk_bf16(S, 0.f) & 0xffffu);
                S = __expf(g[j]) * S + u[j]; }
        }
    }
}
__device__ __forceinline__ void phase_gla_c(const Ctx& c, const Args& a) {
    const bf16_t* Z = (const bf16_t*)(a.ws + WS_Z); const bf16_t* SS = (const bf16_t*)(a.ws + WS_SS); bf16_t* Y = (bf16_t*)(a.ws + WS_Y);
    const int fr = c.lane & 15, fq = c.lane >> 4, w = c.wave;
    const f32x4 gnv = *(const f32x4*)(a.in[I_GLAN] + 16 * w + 4 * fq);
    LAS float* red = (LAS float*)(c.lds + L_RED);
    int h_loaded = -1;
    for (int uu = blockIdx.x; uu < NUNIT; uu += c.G) {
        const int h = uu & 3, n = (uu >> 2) & (NCH - 1), b = uu >> 9, unit = (b * GH + h) * NCH + n;
        __syncthreads();
        if (h != h_loaded) { gla_load_w(c, a, h); h_loaded = h; __syncthreads(); }
        gla_prep<false>(c, a, b, h, n, nullptr, nullptr);
        bf16x8 asf[2], asb[2];
#pragma unroll
        for (int ks = 0; ks < 2; ++ks) { asf[ks] = *(const bf16x8*)(SS + ((size_t)unit * 128 + 16 * w + fr) * 64 + 32 * ks + 8 * fq);
                                          asb[ks] = *(const bf16x8*)(SS + ((size_t)(NUNIT + unit) * 128 + 16 * w + fr) * 64 + 32 * ks + 8 * fq); }
        __syncthreads();
        { const int tt = w & 3;
#pragma unroll
          for (int s2 = 0; s2 < 2; ++s2) { const int ss = 2 * (w >> 2) + s2; f32x4 af = (f32x4){0.f, 0.f, 0.f, 0.f}, ab = af;
              if (ss <= tt) {
#pragma unroll
                  for (int ks = 0; ks < 2; ++ks) af = __builtin_amdgcn_mfma_f32_16x16x32_bf16(gfrag(c.lds + L_KF, 16 * ss, ks, fr, fq), gfrag(c.lds + L_QF, 16 * tt, ks, fr, fq), af, 0, 0, 0); }
              if (ss >= tt) {
#pragma unroll
                  for (int ks = 0; ks < 2; ++ks) ab = __builtin_amdgcn_mfma_f32_16x16x32_bf16(gfrag(c.lds + L_KB, 16 * ss, ks, fr, fq), gfrag(c.lds + L_QB, 16 * tt, ks, fr, fq), ab, 0, 0, 0); }
              const int tpos = 16 * tt + fr, s0 = 16 * ss + 4 * fq; float v[4];
#pragma unroll
              for (int i = 0; i < 4; ++i) v[i] = (s0 + i <= tpos) ? af[i] : ab[i];
              u32x2 pk; pk.x = cvt_pk_bf16(v[0], v[1]); pk.y = cvt_pk_bf16(v[2], v[3]);
              *(LAS u32x2*)(c.lds + L_AC + tpos * GS + s0 * 2) = pk; } }
        __syncthreads();
        bf16x8 av[2];
#pragma unroll
        for (int ks = 0; ks < 2; ++ks) av[ks] = gfrag(c.lds + L_VT, 16 * w, ks, fr, fq);
        f32x4 o[4];
#pragma unroll
        for (int tt = 0; tt < 4; ++tt) { f32x4 acc = (f32x4){0.f, 0.f, 0.f, 0.f};
#pragma unroll
            for (int ks = 0; ks < 2; ++ks) { acc = __builtin_amdgcn_mfma_f32_16x16x32_bf16(av[ks], gfrag(c.lds + L_AC, 16 * tt, ks, fr, fq), acc, 0, 0, 0);
                acc = __builtin_amdgcn_mfma_f32_16x16x32_bf16(asf[ks], gfrag(c.lds + L_QF, 16 * tt, ks, fr, fq), acc, 0, 0, 0);
                acc = __builtin_amdgcn_mfma_f32_16x16x32_bf16(asb[ks], gfrag(c.lds + L_QB, 16 * tt, ks, fr, fq), acc, 0, 0, 0); }
            o[tt] = acc;
            float p = (acc[0] * acc[0] + acc[1] * acc[1]) + (acc[2] * acc[2] + acc[3] * acc[3]);
            p += __shfl_xor(p, 16); p += __shfl_xor(p, 32);
            if (fq == 0) red[w * 64 + 16 * tt + fr] = p; }
        __syncthreads();
#pragma unroll
        for (int tt = 0; tt < 4; ++tt) { const int tpos = 16 * tt + fr; float s = 0.f;
#pragma unroll
            for (int ww = 0; ww < 8; ++ww) s += red[ww * 64 + tpos];
            const float rstd = rsqrtf(s * (1.0f / 128.0f) + EPS);
            const size_t row = (size_t)b * SEQ + n * 64 + tpos;
            const u32x2 gr = *(const u32x2*)(Z + row * NZ + ZG + h * 128 + 16 * w + 4 * fq);
            const float g4[4] = {bf_lo(gr.x), bf_hi(gr.x), bf_lo(gr.y), bf_hi(gr.y)}; float y[4];
#pragma unroll
            for (int i = 0; i < 4; ++i) y[i] = o[tt][i] * rstd * gnv[i] * (g4[i] / (1.0f + __expf(-g4[i])));
            u32x2 pk; pk.x = cvt_pk_bf16(y[0], y[1]); pk.y = cvt_pk_bf16(y[2], y[3]);
            *(u32x2*)(Y + row * D + 512 + h * 128 + 16 * w + 4 * fq) = pk; }
    }
}
__device__ __forceinline__ void phase_final(const Ctx& c, const Args& a) {
    const float* gain = a.in[I_FINN];
    for (int m = c.gw; m < T; m += c.NGW) {
        f32x4* xr = (f32x4*)(a.out + (size_t)m * D) + c.lane; const f32x4* gr = (const f32x4*)gain + c.lane;
        f32x4 v[4]; float s = 0.f;
#pragma unroll
        for (int j = 0; j < 4; ++j) { v[j] = xr[64 * j]; s += (v[j][0] * v[j][0] + v[j][1] * v[j][1]) + (v[j][2] * v[j][2] + v[j][3] * v[j][3]); }
        const float rstd = rsqrtf(wave_sum(s) * (1.f / D) + EPS);
#pragma unroll
        for (int j = 0; j < 4; ++j) xr[64 * j] = v[j] * rstd * gr[64 * j];
    }
}

__device__ __forceinline__ int lane_id_opaque() { int l; asm volatile("v_mbcnt_lo_u32_b32 %0, -1, 0\n\tv_mbcnt_hi_u32_b32 %0, -1, %0" : "=v"(l)); return l; }
typedef __attribute__((address_space(4))) const Args* KArgP;
__device__ __forceinline__ Args load_args() {
    Args a{};
#if defined(__HIP_DEVICE_COMPILE__)
    KArgP p = (KArgP)__builtin_amdgcn_kernarg_segment_ptr(); asm volatile("" : "+s"(p));
#pragma unroll
    for (int i = 0; i < 21; ++i) a.in[i] = p->in[i];
    a.out = p->out; a.ws = p->ws; a.ph_lo = p->ph_lo; a.ph_hi = p->ph_hi;
#endif
    return a;
}
#define XB_TMO      128
#define XB_XCNT(j)  (256  + 64 * (j))
#define XB_XSUB(j)  (1280 + 64 * (j))
#define XB_XGEN(j)  (2304 + 64 * (j))
#define XB_TOP      3328
#define XB_TOPGEN   3392
#define XCD_BAR_WORDS 3456
#define XB_SPIN_CAP (1u << 18)
__device__ __forceinline__ unsigned xb_ld(unsigned* p)              { return __hip_atomic_load(p, __ATOMIC_RELAXED, __HIP_MEMORY_SCOPE_AGENT); }
__device__ __forceinline__ unsigned xb_add(unsigned* p, unsigned v) { return __hip_atomic_fetch_add(p, v, __ATOMIC_RELAXED, __HIP_MEMORY_SCOPE_AGENT); }
__device__ __forceinline__ unsigned xb_xcc_id() { return (unsigned)__builtin_amdgcn_s_getreg((3 << 11) | 20) & 0xFu; }
#define XB_SPIN(cond, bar) do { unsigned _sp = 0; while (cond) { __builtin_amdgcn_s_sleep(1); \
    if ((++_sp & 255u) == 0u) { if (xb_ld(&(bar)[XB_TMO])) break; if (_sp > XB_SPIN_CAP) { atomicAdd(&(bar)[XB_TMO], 1u); break; } } } } while (0)
__device__ __forceinline__ void xcd_barrier_complete(unsigned* bar, unsigned x, unsigned& nloc, unsigned& nx) {
    const unsigned G = gridDim.x;
    unsigned sum, cnt, mine, sp = 0u;
    for (;;) {
        sum = 0u; cnt = 0u; mine = 0u;
#pragma unroll
        for (unsigned j = 0; j < 16; ++j) { const unsigned c = xb_ld(&bar[XB_XCNT(j)]); sum += c; cnt += (c > 0u) ? 1u : 0u; mine = (j == x) ? c : mine; }
        if (sum == G) break;
        __builtin_amdgcn_s_sleep(1);
        if ((++sp & 255u) == 0u) { if (xb_ld(&bar[XB_TMO])) break; if (sp > XB_SPIN_CAP) { atomicAdd(&bar[XB_TMO], 1u); break; } }
    }
    nloc = mine > 0u ? mine : 1u; nx = cnt > 0u ? cnt : 1u;
}
__device__ __forceinline__ void xcd_barrier(unsigned* bar, volatile LAS unsigned* st, bool first) {
    asm volatile("s_waitcnt vmcnt(0)" ::: "memory");
    __syncthreads();
    if (first) {
        const unsigned x = xb_xcc_id();
        __builtin_amdgcn_s_waitcnt(0);
        unsigned nloc = st[0], nx = st[1];
        if (nloc == 0u) { xcd_barrier_complete(bar, x, nloc, nx); st[0] = nloc; st[1] = nx; }
        const unsigned old = xb_add(&bar[XB_XSUB(x)], 1u);
        const unsigned gen = old / nloc;
        if (old + 1u == (gen + 1u) * nloc) {
            __builtin_amdgcn_fence(__ATOMIC_RELEASE, "agent");
            asm volatile("s_waitcnt vmcnt(0)" ::: "memory");
            const unsigned og = xb_add(&bar[XB_TOP], 1u);
            const unsigned tg = og / nx;
            if (og + 1u == (tg + 1u) * nx) xb_add(&bar[XB_TOPGEN], 1u);
            else XB_SPIN(xb_ld(&bar[XB_TOPGEN]) == tg, bar);
            __builtin_amdgcn_fence(__ATOMIC_ACQUIRE, "agent");
            xb_add(&bar[XB_XGEN(x)], 1u);
            asm volatile("s_waitcnt vmcnt(0)" ::: "memory");
        } else {
            XB_SPIN(xb_ld(&bar[XB_XGEN(x)]) == gen, bar);
            __builtin_amdgcn_fence(__ATOMIC_ACQUIRE, "agent");
            asm volatile("s_waitcnt vmcnt(0)" ::: "memory");
        }
    }
    __syncthreads();
}
constexpr int MISC_OFF = 139264;
__global__ void __launch_bounds__(512, 2) mk_fwd(Args args_unused) {
    extern __shared__ __attribute__((aligned(16))) unsigned char lds_raw[];
    const int wave0 = __builtin_amdgcn_readfirstlane(threadIdx.x >> 6);
#define MAKE_CTX() Ctx c; c.lds = (LAS unsigned char*)lds_raw; c.wave = wave0; c.lane = lane_id_opaque(); c.tid = c.wave * 64 + c.lane; c.G = gridDim.x; c.gw = blockIdx.x * 8 + c.wave; c.NGW = c.G * 8
    int lo, hi; { const Args a0 = load_args(); lo = a0.ph_lo; hi = a0.ph_hi; }
#if MK_MODE == 1
#define GRID_BAR(k) cg::this_grid().sync()
#elif MK_MODE == 2
    unsigned* const xbar = (unsigned*)(load_args().ws + WS_CTL);
    volatile LAS unsigned* const xst = (volatile LAS unsigned*)((LAS unsigned char*)lds_raw + MISC_OFF);
    { const int l0 = lane_id_opaque(); if (wave0 == 0 && l0 < 4) xst[l0] = 0u; __syncthreads();
      if (wave0 == 0 && l0 == 0) (void)xb_add(&xbar[XB_XCNT(xb_xcc_id())], 1u); }
#if MK_CG_FIRST
#define GRID_BAR(k) do { if ((k) == 0) cg::this_grid().sync(); else xcd_barrier(xbar, xst, wave0 == 0 && lane_id_opaque() == 0); } while (0)
#else
#define GRID_BAR(k) xcd_barrier(xbar, xst, wave0 == 0 && lane_id_opaque() == 0)
#endif
#else
#define GRID_BAR(k) do { } while (0)
#endif
#ifndef PHASE_MASK
#define PHASE_MASK 0x1fff
#endif
#define IN(k) (((PHASE_MASK >> (k)) & 1) && lo <= (k) && (k) < hi)
#ifndef REP_MASK
#define REP_MASK 0x0
#endif
#define SEAM(k) do { if (IN(k) && IN((k) + 1)) { GRID_BAR(k); } } while (0)
    using namespace pg8;

    if (IN(0)) for (int rep_ = 0; rep_ <= ((REP_MASK >> 0) & 1); ++rep_) { MAKE_CTX(); const Args args = load_args(); phase_prologue(c, args); SEAM(0); }
    if (IN(1)) for (int rep_ = 0; rep_ <= ((REP_MASK >> 1) & 1); ++rep_) { MAKE_CTX(); const Args args = load_args(); unsigned char* ws = args.ws; bf16_t* XN = (bf16_t*)(ws + WS_XN);
        { ProbPlain g{XN, (const bf16_t*)(ws + WS_WIN), D, D, D}; StaticOrder S; S.init(T, NZP, c.G, (int)blockIdx.x);
          EpiZ E{(bf16_t*)(ws + WS_Z), (float*)(ws + WS_LR), (const float*)(ws + WS_RSTD0)};
          gemm_phase<EpiZ, ProbPlain, StaticOrder, true>(c.lds, c.tid, c.wave, g, S, E); }
        __syncthreads();
        { ProbPlain g{(const bf16_t*)(ws + WS_MN), (const bf16_t*)(ws + WS_WXKV), D, D, D}; StaticOrder S; S.init(MROWS, 2 * D, c.G, (int)blockIdx.x);
          EpiKV E{(bf16_t*)(ws + WS_KMEM), (bf16_t*)(ws + WS_VT)};
          gemm_phase<EpiKV, ProbPlain, StaticOrder, true>(c.lds, c.tid, c.wave, g, S, E); }
        SEAM(1);
    }
    if (IN(2)) for (int rep_ = 0; rep_ <= ((REP_MASK >> 2) & 1); ++rep_) { MAKE_CTX(); const Args args = load_args();
#ifndef NO_GLA_A
        phase_gla_A2(c, args);
#endif
#ifndef NO_CONV
        phase_conv(c, args);
#endif
        SEAM(2); }
    if (IN(3)) for (int rep_ = 0; rep_ <= ((REP_MASK >> 3) & 1); ++rep_) { MAKE_CTX(); const Args args = load_args(); phase_gla_B2(c, args); SEAM(3); }
    if (IN(5)) for (int rep_ = 0; rep_ <= ((REP_MASK >> 5) & 1); ++rep_) { MAKE_CTX(); const Args args = load_args(); unsigned char* ws = args.ws; bf16_t* XN = (bf16_t*)(ws + WS_XN); float* SSQ = (float*)(ws + WS_SSQ); (void)XN; (void)SSQ;
        ProbPlain g{(const bf16_t*)(ws + WS_Y), (const bf16_t*)(ws + WS_WOUT), D, D, D}; StaticOrder S; S.init(T, D, c.G, (int)blockIdx.x);
        EpiResB<true> E{(const void*)args.in[I_X], XN, SSQ};
        gemm_phase<EpiResB<true>, ProbPlain, StaticOrder, true>(c.lds, c.tid, c.wave, g, S, E);
        SEAM(5);
    }
    if (IN(6)) for (int rep_ = 0; rep_ <= ((REP_MASK >> 6) & 1); ++rep_) { MAKE_CTX(); const Args args = load_args(); unsigned char* ws = args.ws; bf16_t* XN = (bf16_t*)(ws + WS_XN); float* SSQ = (float*)(ws + WS_SSQ); (void)XN; (void)SSQ;
        ProbPlain g{XN, (const bf16_t*)(ws + WS_WXQ), D, D, D}; StaticOrder S; S.init(T, D, c.G, (int)blockIdx.x);
        EpiScale<0> E{(bf16_t*)(ws + WS_HQ), D, SSQ, 1.0f / 16.0f};
        gemm_phase<EpiScale<0>, ProbPlain, StaticOrder, true>(c.lds, c.tid, c.wave, g, S, E);
        SEAM(6);
    }
    if (IN(7)) for (int rep_ = 0; rep_ <= ((REP_MASK >> 7) & 1); ++rep_) { MAKE_CTX(); const Args args = load_args(); unsigned char* ws = args.ws; bf16_t* XN = (bf16_t*)(ws + WS_XN); float* SSQ = (float*)(ws + WS_SSQ); (void)XN; (void)SSQ;
        ProbQK g{(const bf16_t*)(ws + WS_HQ), (const bf16_t*)(ws + WS_KMEM), D, D, 256}; StaticOrder S; S.init(T, D, c.G, (int)blockIdx.x);
        EpiSoftmax E{(bf16_t*)(ws + WS_P), D, (LAS float*)(c.lds + EPI_LDS_OFF)};
        gemm_phase<EpiSoftmax, ProbQK, StaticOrder, true>(c.lds, c.tid, c.wave, g, S, E);
        SEAM(7);
    }
    if (IN(8)) for (int rep_ = 0; rep_ <= ((REP_MASK >> 8) & 1); ++rep_) { MAKE_CTX(); const Args args = load_args(); unsigned char* ws = args.ws; bf16_t* XN = (bf16_t*)(ws + WS_XN); float* SSQ = (float*)(ws + WS_SSQ); (void)XN; (void)SSQ;
        ProbPV g{(const bf16_t*)(ws + WS_P), (const bf16_t*)(ws + WS_VT), D, 256, 256}; StaticOrder S; S.init(T, D, c.G, (int)blockIdx.x);
        EpiBf16 E{(bf16_t*)(ws + WS_O), D};
        gemm_phase<EpiBf16, ProbPV, StaticOrder, true>(c.lds, c.tid, c.wave, g, S, E);
        SEAM(8);
    }
    if (IN(9)) for (int rep_ = 0; rep_ <= ((REP_MASK >> 9) & 1); ++rep_) { MAKE_CTX(); const Args args = load_args(); unsigned char* ws = args.ws; bf16_t* XN = (bf16_t*)(ws + WS_XN); float* SSQ = (float*)(ws + WS_SSQ); (void)XN; (void)SSQ;
        ProbPlain g{(const bf16_t*)(ws + WS_O), (const bf16_t*)(ws + WS_WXO), D, D, D}; StaticOrder S; S.init(T, D, c.G, (int)blockIdx.x);
        EpiResB<false> E{(const void*)XN, (bf16_t*)(ws + WS_XB2), SSQ};
        gemm_phase<EpiResB<false>, ProbPlain, StaticOrder, true>(c.lds, c.tid, c.wave, g, S, E);
        SEAM(9);
    }
    if (IN(10)) for (int rep_ = 0; rep_ <= ((REP_MASK >> 10) & 1); ++rep_) { MAKE_CTX(); const Args args = load_args(); unsigned char* ws = args.ws; bf16_t* XN = (bf16_t*)(ws + WS_XN); float* SSQ = (float*)(ws + WS_SSQ); (void)XN; (void)SSQ;
        ProbPlain g{(const bf16_t*)(ws + WS_XB2), (const bf16_t*)(ws + WS_WUP), D, D, D}; StaticOrder S; S.init(T, FF, c.G, (int)blockIdx.x);
        EpiScale<1> E{(bf16_t*)(ws + WS_U), FF, SSQ, 1.0f};
        gemm_phase<EpiScale<1>, ProbPlain, StaticOrder, true>(c.lds, c.tid, c.wave, g, S, E);
        SEAM(10);
    }
    if (IN(11)) for (int rep_ = 0; rep_ <= ((REP_MASK >> 11) & 1); ++rep_) { MAKE_CTX(); const Args args = load_args(); unsigned char* ws = args.ws; bf16_t* XN = (bf16_t*)(ws + WS_XN); float* SSQ = (float*)(ws + WS_SSQ); (void)XN; (void)SSQ;
        ProbPlain g{(const bf16_t*)(ws + WS_U), (const bf16_t*)(ws + WS_WDN), FF, FF, FF}; StaticOrder S; S.init(T, D, c.G, (int)blockIdx.x);
        EpiResF E{(const bf16_t*)(ws + WS_XB2), args.out};
        gemm_phase<EpiResF, ProbPlain, StaticOrder, true>(c.lds, c.tid, c.wave, g, S, E);
        SEAM(11);
    }
    if (IN(12)) for (int rep_ = 0; rep_ <= ((REP_MASK >> 12) & 1); ++rep_) { MAKE_CTX(); const Args args = load_args(); phase_final(c, args); }
#undef IN
#undef SEAM
#undef GRID_BAR
}

extern "C" void kernel_launch(void* const* d_in, const int* in_sizes, int n_in, void* d_out, int out_size, void* d_ws, size_t ws_size, hipStream_t stream) {
    static int grid = 0;
    if (grid == 0) {
        if (n_in != 21 || in_sizes[0] != T * D || out_size != T * D || ws_size < WS_END) {
            fprintf(stderr, "kernel_launch: unexpected shapes: n_in %d in0 %d out %d ws %zu (need %zu); nothing launched\n", n_in, n_in > 0 ? in_sizes[0] : -1, out_size, ws_size, (size_t)WS_END); grid = -1; return; }
        int dev = 0, cus = 0, per_cu = 0;
        if (hipGetDevice(&dev) != hipSuccess || hipDeviceGetAttribute(&cus, hipDeviceAttributeMultiprocessorCount, dev) != hipSuccess) { fprintf(stderr, "kernel_launch: device query failed\n"); grid = -1; return; }
        if (hipFuncSetAttribute((const void*)mk_fwd, hipFuncAttributeMaxDynamicSharedMemorySize, LDS_BYTES) != hipSuccess) { fprintf(stderr, "kernel_launch: hipFuncSetAttribute failed\n"); grid = -1; return; }
        if (hipOccupancyMaxActiveBlocksPerMultiprocessor(&per_cu, (const void*)mk_fwd, 512, LDS_BYTES) != hipSuccess || per_cu < 1) { fprintf(stderr, "kernel_launch: occupancy query says %d blocks per CU\n", per_cu); (void)hipGetLastError(); grid = -1; return; }
        grid = cus * (per_cu < 1 ? 1 : 1);
        fprintf(stderr, "kernel_launch: %d CUs, occupancy query %d per CU, grid %d\n", cus, per_cu, grid);
    }
    if (grid < 0) return;
    Args a{};
    for (int i = 0; i < 21; ++i) a.in[i] = (const float*)d_in[i];
    a.out = (float*)d_out; a.ws = (unsigned char*)d_ws;
#if MK_MODE == 0
    for (int p = 0; p < N_PHASES; ++p) { a.ph_lo = p; a.ph_hi = p + 1; hipLaunchKernelGGL(mk_fwd, dim3(grid), dim3(512), LDS_BYTES, stream, a); }
#else
    a.ph_lo = 0; a.ph_hi = N_PHASES;
#if MK_MODE == 2
    if (hipMemsetAsync((char*)d_ws + WS_CTL, 0, 65536, stream) != hipSuccess) { fprintf(stderr, "kernel_launch: memset of the barrier words failed\n"); return; }
#endif
#if MK_MODE == 2 && !MK_CG_FIRST
    hipLaunchKernelGGL(mk_fwd, dim3(grid), dim3(512), LDS_BYTES, stream, a);
#else
    void* kargs[] = {&a};
    hipError_t e = hipLaunchCooperativeKernel((const void*)mk_fwd, dim3(grid), dim3(512), kargs, LDS_BYTES, stream);
    if (e != hipSuccess) fprintf(stderr, "kernel_launch: cooperative launch failed: %s (grid %d)\n", hipGetErrorString(e), grid);
#endif
#endif
}
```
